# Optimizing an MI355X kernel written in HIP

```python
import jax, jax.numpy as jnp
from jax import lax
import numpy as np

D_MODEL = 2048
BATCH = 8
SEQ = 2048
DEPTH = 1

HEAD_DIM = 128
N_MIX_HEADS = D_MODEL // HEAD_DIM
N_MEM_HEADS = 4
N_SGU_HEADS = (N_MIX_HEADS - N_MEM_HEADS) // 2
N_CONV_GROUPS = N_MIX_HEADS - N_MEM_HEADS - N_SGU_HEADS
D_SGU = N_SGU_HEADS * HEAD_DIM
D_CONV = N_CONV_GROUPS * HEAD_DIM
D_MEM = N_MEM_HEADS * HEAD_DIM
D_MIX = D_SGU + D_CONV + D_MEM
D_IN = 2 * D_SGU + 3 * D_CONV + D_MEM
CHUNK = 128
CONV_W = 3
N_MEM = 256
D_FF = 4 * D_MODEL
EPS = 1e-6

kernel_name = "hybrid_sgu_shortconv_memattn_block"


def rms_norm(x, g):
    xf = x.astype(jnp.float32)
    y = xf * lax.rsqrt(jnp.mean(xf * xf, axis=-1, keepdims=True) + EPS)
    return (y * g.astype(jnp.float32)).astype(x.dtype)


def layer_norm(x, g, b):
    xf = x.astype(jnp.float32)
    mu = jnp.mean(xf, axis=-1, keepdims=True)
    xc = xf - mu
    y = xc * lax.rsqrt(jnp.mean(xc * xc, axis=-1, keepdims=True) + EPS)
    return (y * g.astype(jnp.float32) + b.astype(jnp.float32)).astype(x.dtype)


def chunked_spatial_gating(u, v, ln_g, ln_b, w_s, b_s):
    bsz, s, _ = v.shape
    u = jax.nn.gelu(u)
    v = layer_norm(jax.nn.gelu(v), ln_g, ln_b)
    vc = v.reshape(bsz, s // CHUNK, CHUNK, N_SGU_HEADS, HEAD_DIM)
    causal = jnp.tril(jnp.ones((CHUNK, CHUNK), dtype=bool))
    w = jnp.where(causal[None], w_s, jnp.zeros_like(w_s))
    mixed = jnp.einsum('hts,bcshd->bcthd', w, vc) + b_s.T[:, :, None]
    return u * mixed.reshape(bsz, s, D_SGU)


def short_gated_conv(b_gate, c_gate, xin, conv_w):
    xc = c_gate * xin
    y = lax.conv_general_dilated(
        xc, conv_w[:, None, :].astype(xc.dtype),
        window_strides=(1,), padding=[(CONV_W - 1, 0)],
        dimension_numbers=('NWC', 'WIO', 'NWC'),
        feature_group_count=D_CONV)
    return b_gate * y


def memory_attention(q, mem_n, w_kv):
    bsz, s, _ = q.shape
    m = mem_n.shape[1]
    k, v = jnp.split(mem_n @ w_kv, 2, axis=-1)
    q = q.reshape(bsz, s, N_MEM_HEADS, HEAD_DIM) * (HEAD_DIM ** -0.5)
    k = k.reshape(bsz, m, N_MEM_HEADS, HEAD_DIM)
    v = v.reshape(bsz, m, N_MEM_HEADS, HEAD_DIM)
    scores = jnp.einsum('bshd,bmhd->bhsm', q, k).astype(jnp.float32)
    p = jax.nn.softmax(scores, axis=-1).astype(v.dtype)
    o = jnp.einsum('bhsm,bmhd->bshd', p, v)
    return o.reshape(bsz, s, D_MEM)


def setup_inputs(seed: int = 0) -> dict:
    key = jax.random.key(seed)
    ks = jax.random.split(key, 20)
    f32 = jnp.float32
    nrm = lambda k, shape, scale: jax.random.normal(k, shape, f32) * scale
    gain = lambda k, shape: 1.0 + 0.02 * jax.random.normal(k, shape, f32)
    return {
        "x": jax.random.normal(ks[0], (BATCH, SEQ, D_MODEL), f32),
        "mem": jax.random.normal(ks[1], (BATCH, N_MEM, D_MODEL), f32),
        "g_mix": gain(ks[2], (DEPTH, D_MODEL)),
        "w_in": nrm(ks[3], (DEPTH, D_MODEL, D_IN), D_MODEL ** -0.5),
        "ln_v_g": gain(ks[4], (DEPTH, D_SGU)),
        "ln_v_b": nrm(ks[5], (DEPTH, D_SGU), 0.02),
        "w_s": nrm(ks[6], (DEPTH, N_SGU_HEADS, CHUNK, CHUNK), CHUNK ** -0.5),
        "b_s": gain(ks[7], (DEPTH, N_SGU_HEADS, CHUNK)),
        "conv_w": nrm(ks[8], (DEPTH, CONV_W, D_CONV), CONV_W ** -0.5),
        "g_mem": gain(ks[9], (DEPTH, D_MODEL)),
        "w_kv": nrm(ks[10], (DEPTH, D_MODEL, 2 * D_MEM), D_MODEL ** -0.5),
        "g_head": gain(ks[11], (DEPTH, D_MIX)),
        "w_o": nrm(ks[12], (DEPTH, D_MIX, D_MODEL), D_MIX ** -0.5),
        "g_ffn": gain(ks[13], (DEPTH, D_MODEL)),
        "w_ffn1": nrm(ks[14], (DEPTH, D_MODEL, D_FF), D_MODEL ** -0.5),
        "w_ffn2": nrm(ks[15], (DEPTH, D_FF, D_MODEL), D_FF ** -0.5),
        "g_final": gain(ks[16], (D_MODEL,)),
    }


def reference(x, mem, g_mix, w_in, ln_v_g, ln_v_b, w_s, b_s, conv_w, g_mem,
              w_kv, g_head, w_o, g_ffn, w_ffn1, w_ffn2, g_final):
    bsz, s, _ = x.shape
    split_at = np.cumsum([D_SGU, D_SGU, D_CONV, D_CONV, D_CONV])
    for l in range(DEPTH):
        h = rms_norm(x, g_mix[l])
        proj = h @ w_in[l]
        u, v, b_gate, c_gate, xin, q = jnp.split(proj, split_at, axis=-1)
        a_out = chunked_spatial_gating(u, v, ln_v_g[l], ln_v_b[l], w_s[l], b_s[l])
        c_out = short_gated_conv(b_gate, c_gate, xin, conv_w[l])
        m_out = memory_attention(q, rms_norm(mem, g_mem[l]), w_kv[l])
        heads = jnp.concatenate([a_out, c_out, m_out], axis=-1)
        heads = rms_norm(heads.reshape(bsz, s, N_MIX_HEADS, HEAD_DIM),
                         jnp.ones((HEAD_DIM,), heads.dtype)).reshape(bsz, s, D_MIX)
        x = x + (heads * g_head[l]) @ w_o[l]
        f = rms_norm(x, g_ffn[l]) @ w_ffn1[l]
        x = x + jnp.square(jax.nn.relu(f)) @ w_ffn2[l]
    return rms_norm(x, g_final)
```

```cpp
#include <hip/hip_runtime.h>
#include <cstdio>
#include <cstdint>
namespace pg8 {
#define PG8_LAS __attribute__((address_space(3)))
typedef unsigned short bf16_t;
typedef short bf16x8 __attribute__((ext_vector_type(8)));
typedef float f32x4 __attribute__((ext_vector_type(4)));
typedef unsigned u32x4 __attribute__((ext_vector_type(4)));
constexpr int BM = 256, BK = 64, HALF = 128, HTB = HALF * BK * 2  , STAGE_BYTES = 8 * HTB, NXCD = 8, WGM = 8;

__host__ __device__ __forceinline__ int lds_byte(int r, int c) { const int st = (r >> 4) * 2 + (c >> 5), rr = r & 15, cc = c & 31, ob = rr * 64 + cc * 2; return st * 1024 + (ob ^ (((ob >> 9) & 1) << 5)); }
__host__ __device__ __forceinline__ void stage_rc(int b, int& R, int& C) { const int st = b / 1024, sb = b % 1024, swz = sb ^ (((sb >> 9) & 1) << 5); R = (st >> 1) * 16 + swz / 64; C = (st & 1) * 32 + (swz % 64) / 2; }
__host__ __device__ __forceinline__ int perm32(int rho) { const int n = rho >> 4, i = rho & 15; return 8 * (i >> 2) + 4 * n + (i & 3); }

struct Unit { int pm, pn; };
struct Gemm { const bf16_t* A; const bf16_t* Bt; int M, N, K; };

struct StaticOrder {
    int nM, nN, nwg, G, c;
    __host__ __device__ void init(int M, int N, int G_, int c_) { nM = M / BM; nN = N / BM; nwg = nM * nN; G = G_; c = c_; }
    __host__ __device__ bool next(int i, Unit& u) const {
        const long L = (long)i * G + c; if (L >= nwg) return false;
        int wgid = (int)L; { const int q = nwg / NXCD, r = nwg % NXCD, xcd = wgid % NXCD, off = wgid / NXCD; wgid = (xcd < r ? xcd * (q + 1) : r * (q + 1) + (xcd - r) * q) + off; }
        const int nig = WGM * nN, gid = wgid / nig, fm = gid * WGM, gsz = (nM - fm) < WGM ? (nM - fm) : WGM;
        u.pm = fm + ((wgid % nig) % gsz); u.pn = (wgid % nig) / gsz; return true;
    }
    __device__ __forceinline__ void a_ready(const Unit&) const {}
    __device__ __forceinline__ void done(const Unit&) const {}
};

__device__ __forceinline__ unsigned cvt_pk_bf16(float lo, float hi) { unsigned r; asm volatile("v_cvt_pk_bf16_f32 %0, %1, %2" : "=v"(r) : "v"(lo), "v"(hi)); return r; }
typedef float f32x2 __attribute__((ext_vector_type(2)));
typedef unsigned u32x2 __attribute__((ext_vector_type(2)));
__device__ __forceinline__ float gelu_t(float x) {
    const float t = x * (2.302208198f + 0.1029432397f * x * x);
    return x * __builtin_amdgcn_rcpf(1.0f + __builtin_amdgcn_exp2f(-t));
}
constexpr int E_DIN = 4352, E_DM = 2048, E_DFF = 8192;
constexpr float E_EPS = 1e-6f;
constexpr int PAN_MEMN = 64, PAN_WIN = 72, PAN_WKV = 89;

struct Order1 {
    StaticOrder so; int G, c;
    __device__ void init(int G_, int c_) { so.init(16384, E_DIN, G_, c_); G = G_; c = c_; }
    __device__ bool next(int i, Unit& u) const {
        const int L = i * G + c;
        if (L < 1088) { Unit t; so.next(i, t); u.pm = t.pm; u.pn = PAN_WIN + t.pn; return true; }
        const int r = L - 1088;
        if (r < 16) { u.pm = PAN_MEMN + (r & 7); u.pn = PAN_WKV + (r >> 3); return true; }
        if (r < 32) { const int q = r - 16; u.pm = PAN_WKV + 2 + (q >> 3); u.pn = PAN_MEMN + (q & 7); return true; }
        return false;
    }
    __device__ __forceinline__ void a_ready(const Unit&) const {}
    __device__ __forceinline__ void done(const Unit&) const {}
};

struct Epi1 {
    static constexpr bool PERM = true, AFTER_DRAIN = false;
    bf16_t* proj; bf16_t* kmat; bf16_t* vt; float* vstats; float qscale;
    __device__ __forceinline__ void operator()(const f32x4 (&acc)[2][2][4][2], const Unit& u, int wr, int wc, int fr, int fq) const {
        bf16_t* base; int ld, mode, rowt, colt, j = 0;
        const int pa = u.pm, pb = u.pn;
        if (pb >= PAN_WIN && pb < PAN_WKV) { j = pb - PAN_WIN; base = proj; ld = E_DIN; rowt = pa * 256; colt = j * 256; mode = j < 3 ? 1 : (j < 6 ? 2 : (j >= 15 ? 3 : 0)); }
        else if (pb >= PAN_WKV) { base = kmat; ld = 512; rowt = (pa - PAN_MEMN) * 256; colt = (pb - PAN_WKV) * 256; mode = 0; }
        else { base = vt; ld = 2048; rowt = (pa - PAN_WKV - 2) * 256; colt = (pb - PAN_MEMN) * 256; mode = 0; }
        const int row0 = rowt + wr * 64 + fr, col0 = colt + wc * 32 + 8 * fq;
        const float sc = mode == 3 ? qscale : 1.0f;
#pragma unroll
        for (int ai = 0; ai < 2; ++ai)
#pragma unroll
            for (int m = 0; m < 4; ++m) {
                const int row = row0 + ai * HALF + m * 16;
                bf16_t* rowp = base + (size_t)row * ld + col0;
                float s1 = 0.f, s2 = 0.f;
#pragma unroll
                for (int bj = 0; bj < 2; ++bj) {
                    f32x4 v0 = acc[ai][bj][m][0], v1 = acc[ai][bj][m][1];
                    if (mode == 1 || mode == 2) {
#pragma unroll
                        for (int e = 0; e < 4; ++e) { v0[e] = gelu_t(v0[e]); v1[e] = gelu_t(v1[e]); }
                        if (mode == 2) {
#pragma unroll
                            for (int e = 0; e < 4; ++e) { s1 += v0[e] + v1[e]; s2 += v0[e] * v0[e] + v1[e] * v1[e]; }
                        }
                    } else { v0 = v0 * sc; v1 = v1 * sc; }
                    u32x4 w; w.x = cvt_pk_bf16(v0[0], v0[1]); w.y = cvt_pk_bf16(v0[2], v0[3]); w.z = cvt_pk_bf16(v1[0], v1[1]); w.w = cvt_pk_bf16(v1[2], v1[3]);
                    *(u32x4*)(rowp + bj * HALF) = w;
                }
                if (mode == 2) {
                    s1 += __shfl_xor(s1, 16); s1 += __shfl_xor(s1, 32); s2 += __shfl_xor(s2, 16); s2 += __shfl_xor(s2, 32);
                    if (fq == 0) *(f32x2*)(vstats + ((size_t)row * 12 + (j - 3) * 4 + wc) * 2) = (f32x2){s1, s2};
                }
            }
    }
};
struct Epi3 {
    static constexpr bool PERM = false, AFTER_DRAIN = false;
    const float* x; float* out; bf16_t* x1b; float* ssq;
    __device__ __forceinline__ void operator()(const f32x4 (&acc)[2][2][4][2], const Unit& u, int wr, int wc, int fr, int fq) const {
        const int row0 = u.pm * BM + wr * 64 + fr, col0 = u.pn * BM + wc * 32 + 4 * fq;
#pragma unroll
        for (int ai = 0; ai < 2; ++ai)
#pragma unroll
            for (int m = 0; m < 4; ++m) {
                const int row = row0 + ai * HALF + m * 16; const size_t off = (size_t)row * E_DM + col0; float s = 0.f;
#pragma unroll
                for (int bj = 0; bj < 2; ++bj)
#pragma unroll
                    for (int n = 0; n < 2; ++n) {
                        const f32x4 o = *(const f32x4*)(x + off + bj * HALF + n * 16) + acc[ai][bj][m][n];
                        *(f32x4*)(out + off + bj * HALF + n * 16) = o;
                        s += (o[0] * o[0] + o[1] * o[1]) + (o[2] * o[2] + o[3] * o[3]);
                        u32x2 w; w.x = cvt_pk_bf16(o[0], o[1]); w.y = cvt_pk_bf16(o[2], o[3]);
                        *(u32x2*)(x1b + off + bj * HALF + n * 16) = w;
                    }
                s += __shfl_xor(s, 16); s += __shfl_xor(s, 32);
                if (fq == 0) ssq[(size_t)row * 32 + u.pn * 4 + wc] = s;
            }
    }
};
struct Epi4 {
    static constexpr bool PERM = true, AFTER_DRAIN = false;
    bf16_t* hid; const float* ssq;
    __device__ __forceinline__ void operator()(const f32x4 (&acc)[2][2][4][2], const Unit& u, int wr, int wc, int fr, int fq) const {
        const int row0 = u.pm * BM + wr * 64 + fr, col0 = u.pn * BM + wc * 32 + 8 * fq;
#pragma unroll
        for (int ai = 0; ai < 2; ++ai)
#pragma unroll
            for (int m = 0; m < 4; ++m) {
                const int row = row0 + ai * HALF + m * 16;
                const f32x4 p0 = *(const f32x4*)(ssq + (size_t)row * 32 + 8 * fq), p1 = *(const f32x4*)(ssq + (size_t)row * 32 + 8 * fq + 4);
                float s = ((p0[0] + p0[1]) + (p0[2] + p0[3])) + ((p1[0] + p1[1]) + (p1[2] + p1[3]));
                s += __shfl_xor(s, 16); s += __shfl_xor(s, 32);
                const float rinv = __builtin_amdgcn_rsqf(s * (1.0f / E_DM) + E_EPS);
                bf16_t* rowp = hid + (size_t)row * E_DFF + col0;
#pragma unroll
                for (int bj = 0; bj < 2; ++bj) {
                    f32x4 v0 = acc[ai][bj][m][0] * rinv, v1 = acc[ai][bj][m][1] * rinv;
#pragma unroll
                    for (int e = 0; e < 4; ++e) { const float a = fmaxf(v0[e], 0.f), b = fmaxf(v1[e], 0.f); v0[e] = a * a; v1[e] = b * b; }
                    u32x4 w; w.x = cvt_pk_bf16(v0[0], v0[1]); w.y = cvt_pk_bf16(v0[2], v0[3]); w.z = cvt_pk_bf16(v1[0], v1[1]); w.w = cvt_pk_bf16(v1[2], v1[3]);
                    *(u32x4*)(rowp + bj * HALF) = w;
                }
            }
    }
};
struct Epi5 {
    static constexpr bool PERM = false, AFTER_DRAIN = false;
    float* out; float* ssq;
    __device__ __forceinline__ void operator()(const f32x4 (&acc)[2][2][4][2], const Unit& u, int wr, int wc, int fr, int fq) const {
        const int row0 = u.pm * BM + wr * 64 + fr, col0 = u.pn * BM + wc * 32 + 4 * fq;
#pragma unroll
        for (int ai = 0; ai < 2; ++ai)
#pragma unroll
            for (int m = 0; m < 4; ++m) {
                const int row = row0 + ai * HALF + m * 16; const size_t off = (size_t)row * E_DM + col0; float s = 0.f;
#pragma unroll
                for (int bj = 0; bj < 2; ++bj)
#pragma unroll
                    for (int n = 0; n < 2; ++n) {
                        const f32x4 o = *(const f32x4*)(out + off + bj * HALF + n * 16) + acc[ai][bj][m][n];
                        *(f32x4*)(out + off + bj * HALF + n * 16) = o;
                        s += (o[0] * o[0] + o[1] * o[1]) + (o[2] * o[2] + o[3] * o[3]);
                    }
                s += __shfl_xor(s, 16); s += __shfl_xor(s, 32);
                if (fq == 0) ssq[(size_t)row * 32 + u.pn * 4 + wc] = s;
            }
    }
};

template <class Epi, class Sched, bool ALIGN_EPI = false, bool SP2 = false>
__device__ __forceinline__ void gemm_phase(PG8_LAS unsigned char* lds, const Gemm g, const Sched& S, const Epi& E) {
    const int tid = threadIdx.x, wid = __builtin_amdgcn_readfirstlane(tid >> 6), lane = tid & 63, wr = wid >> 2, wc = wid & 3, fr = lane & 15, fq = lane >> 4;
    const int K = g.K, nt = K / BK;
    unsigned voffA[2], voffB[2];
#pragma unroll
    for (int i = 0; i < 2; ++i) { int R, C; stage_rc(tid * 16 + i * 8192, R, C); const int Rb = Epi::PERM ? ((R & ~31) + perm32(R & 31)) : R;
        voffA[i] = (unsigned)(R * K + C) * 2u; voffB[i] = (unsigned)(Rb * K + C) * 2u; }
    const size_t kstep = (size_t)(BK * 2);
    const size_t hstep = (size_t)HALF * K * 2;
    const size_t tstep = 2 * hstep;
    const unsigned ldsw = (unsigned)wid * 1024u;
    const int aoff = lds_byte(wr * 64 + fr, fq * 8), boff = lds_byte(wc * 32 + fr, fq * 8);
#define PG8_SA(b, h) (((b) * 2 + (h)) * HTB)
#define PG8_SB(b, h) ((4 + (b) * 2 + (h)) * HTB)
#define PG8_STAGE(bufoff, gbase, voff) do { _Pragma("unroll") for (int _i = 0; _i < 2; ++_i) \
        __builtin_amdgcn_global_load_lds((const unsigned*)((const char*)(gbase) + (voff)[_i]), (PG8_LAS unsigned*)(lds + (bufoff) + ldsw + _i * 8192), 16, 0, 0); } while (0)
#define PG8_LDA(dst, b, h) do { _Pragma("unroll") for (int m = 0; m < 4; ++m) _Pragma("unroll") for (int k = 0; k < 2; ++k) dst[m][k] = *(const PG8_LAS bf16x8*)(lds + PG8_SA(b, h) + aoff + m * 2048 + k * 1024); } while (0)
#define PG8_LDB(dst, b, h) do { _Pragma("unroll") for (int n = 0; n < 2; ++n) _Pragma("unroll") for (int k = 0; k < 2; ++k) dst[n][k] = *(const PG8_LAS bf16x8*)(lds + PG8_SB(b, h) + boff + n * 2048 + k * 1024); } while (0)
#define PG8_MMA(ai, bj, At, Bt) do { __builtin_amdgcn_s_setprio(1); _Pragma("unroll") for (int m = 0; m < 4; ++m) _Pragma("unroll") for (int n = 0; n < 2; ++n) _Pragma("unroll") for (int k = 0; k < 2; ++k) \
        acc[ai][bj][m][n] = __builtin_amdgcn_mfma_f32_16x16x32_bf16(Bt[n][k], At[m][k], acc[ai][bj][m][n], 0, 0, 0); __builtin_amdgcn_s_setprio(0); } while (0)
#define PG8_WAIT_V(n) asm volatile("s_waitcnt vmcnt(" #n ")" ::: "memory")
#define PG8_WAIT_L(n) asm volatile("s_waitcnt lgkmcnt(" #n ")" ::: "memory")
#define PG8_BAR __builtin_amdgcn_s_barrier()
#define PG8_SCHED __builtin_amdgcn_sched_barrier(0)
    Unit cur, nxt; int ui = 0;
    if (!S.next(0, cur)) return;
    f32x4 acc[2][2][4][2];
#pragma unroll
    for (int a = 0; a < 2; ++a)
#pragma unroll
        for (int b = 0; b < 2; ++b)
#pragma unroll
            for (int m = 0; m < 4; ++m)
#pragma unroll
                for (int n = 0; n < 2; ++n) acc[a][b][m][n] = (f32x4){0.f, 0.f, 0.f, 0.f};
    bf16x8 At[4][2], B0[2][2], B1[2][2];
    const char* cA = (const char*)g.A + (size_t)cur.pm * tstep; const char* cB = (const char*)g.Bt + (size_t)cur.pn * tstep;
    S.a_ready(cur);
    if constexpr (SP2) {
        PG8_STAGE(PG8_SB(0, 0), cB, voffB); PG8_STAGE(PG8_SB(0, 1), cB + hstep, voffB); PG8_STAGE(PG8_SA(0, 0), cA, voffA); PG8_STAGE(PG8_SA(0, 1), cA + hstep, voffA);
        if (wr == 1) PG8_BAR;
        PG8_WAIT_V(2); PG8_BAR;
        PG8_STAGE(PG8_SB(1, 0), cB + kstep, voffB); PG8_STAGE(PG8_SA(1, 0), cA + kstep, voffA); PG8_STAGE(PG8_SB(1, 1), cB + hstep + kstep, voffB);
        PG8_WAIT_V(6); PG8_BAR;
    } else {
        PG8_STAGE(PG8_SB(0, 0), cB, voffB); PG8_STAGE(PG8_SA(0, 0), cA, voffA); PG8_STAGE(PG8_SB(0, 1), cB + hstep, voffB); PG8_STAGE(PG8_SA(0, 1), cA + hstep, voffA);
        if (wr == 1) PG8_BAR;
        PG8_WAIT_V(4); PG8_BAR;
        PG8_STAGE(PG8_SB(1, 0), cB + kstep, voffB); PG8_STAGE(PG8_SA(1, 0), cA + kstep, voffA); PG8_STAGE(PG8_SB(1, 1), cB + hstep + kstep, voffB);
        PG8_WAIT_V(6); PG8_BAR;
    }
    for (;;) {
        const bool has_next = S.next(ui + 1, nxt);
        const char* nA = has_next ? (const char*)g.A + (size_t)nxt.pm * tstep : cA; const char* nB = has_next ? (const char*)g.Bt + (size_t)nxt.pn * tstep : cB;
        for (int t = 0; t < nt; t += 2) {
            const bool last = (t == nt - 2);
            const char* a1 = cA + (size_t)(t + 1) * kstep;
            const char* a2 = last ? nA : cA + (size_t)(t + 2) * kstep; const char* b2 = last ? nB : cB + (size_t)(t + 2) * kstep;
            const char* a3 = a2 + kstep; const char* b3 = b2 + kstep;
            if (last && has_next) S.a_ready(nxt);
            if constexpr (SP2) {
            PG8_LDB(B0, 0, 0); PG8_LDB(B1, 0, 1); PG8_SCHED; PG8_LDA(At, 0, 0); PG8_STAGE(PG8_SA(1, 1), a1 + hstep, voffA);
            PG8_WAIT_V(8); PG8_WAIT_L(0); PG8_BAR; PG8_MMA(0, 0, At, B0); PG8_MMA(0, 1, At, B1); PG8_BAR; PG8_SCHED;
            PG8_LDA(At, 0, 1); PG8_STAGE(PG8_SB(0, 0), b2, voffB); PG8_STAGE(PG8_SB(0, 1), b2 + hstep, voffB); PG8_STAGE(PG8_SA(0, 0), a2, voffA);
            PG8_WAIT_V(8); PG8_WAIT_L(0); PG8_BAR; PG8_MMA(1, 0, At, B0); PG8_MMA(1, 1, At, B1); PG8_BAR; PG8_SCHED;
            PG8_LDB(B0, 1, 0); PG8_LDB(B1, 1, 1); PG8_SCHED; PG8_LDA(At, 1, 0); PG8_STAGE(PG8_SA(0, 1), a2 + hstep, voffA);
            PG8_WAIT_V(8); PG8_WAIT_L(0); PG8_BAR; PG8_MMA(0, 0, At, B0); PG8_MMA(0, 1, At, B1); PG8_BAR; PG8_SCHED;
            PG8_LDA(At, 1, 1); PG8_STAGE(PG8_SB(1, 0), b3, voffB); PG8_STAGE(PG8_SB(1, 1), b3 + hstep, voffB); PG8_STAGE(PG8_SA(1, 0), a3, voffA);
            PG8_WAIT_V(8); PG8_WAIT_L(0); PG8_BAR; PG8_MMA(1, 0, At, B0); PG8_MMA(1, 1, At, B1); PG8_BAR; PG8_SCHED;
            } else {
            PG8_LDB(B0, 0, 0); PG8_SCHED; PG8_LDA(At, 0, 0); PG8_STAGE(PG8_SA(1, 1), a1 + hstep, voffA);
            PG8_WAIT_L(8); PG8_BAR; PG8_WAIT_L(0); PG8_MMA(0, 0, At, B0); PG8_BAR; PG8_SCHED;
            PG8_LDB(B1, 0, 1); PG8_STAGE(PG8_SB(0, 0), b2, voffB);
            PG8_BAR; PG8_WAIT_L(0); PG8_MMA(0, 1, At, B1); PG8_BAR;
            PG8_LDA(At, 0, 1); PG8_STAGE(PG8_SA(0, 0), a2, voffA);
            PG8_BAR; PG8_WAIT_L(0); PG8_MMA(1, 0, At, B0); PG8_BAR; PG8_SCHED;
            PG8_STAGE(PG8_SB(0, 1), b2 + hstep, voffB);
            PG8_WAIT_V(6); PG8_BAR; PG8_MMA(1, 1, At, B1); PG8_BAR;
            PG8_LDB(B0, 1, 0); PG8_SCHED; PG8_LDA(At, 1, 0); PG8_STAGE(PG8_SA(0, 1), a2 + hstep, voffA);
            PG8_WAIT_L(8); PG8_BAR; PG8_WAIT_L(0); PG8_MMA(0, 0, At, B0); PG8_BAR; PG8_SCHED;
            PG8_LDB(B1, 1, 1); PG8_STAGE(PG8_SB(1, 0), b3, voffB);
            PG8_BAR; PG8_WAIT_L(0); PG8_MMA(0, 1, At, B1); PG8_BAR;
            PG8_LDA(At, 1, 1); PG8_STAGE(PG8_SA(1, 0), a3, voffA);
            PG8_BAR; PG8_WAIT_L(0); PG8_MMA(1, 0, At, B0); PG8_BAR; PG8_SCHED;
            PG8_STAGE(PG8_SB(1, 1), b3 + hstep, voffB);
            PG8_WAIT_V(6); PG8_BAR; PG8_MMA(1, 1, At, B1); PG8_BAR;
            }
        }
        if constexpr (ALIGN_EPI) { if (wr == 0) PG8_BAR; }
        if constexpr (!Epi::AFTER_DRAIN) { E(acc, cur, wr, wc, fr, fq); S.done(cur); }
        if (!has_next) break;
#pragma unroll
        for (int a = 0; a < 2; ++a)
#pragma unroll
            for (int b = 0; b < 2; ++b)
#pragma unroll
                for (int m = 0; m < 4; ++m)
#pragma unroll
                    for (int n = 0; n < 2; ++n) acc[a][b][m][n] = (f32x4){0.f, 0.f, 0.f, 0.f};
        cur = nxt; cA = nA; cB = nB; ++ui;
        if constexpr (ALIGN_EPI) { if (wr == 1) PG8_BAR; }
    }
    PG8_WAIT_V(0);
    if constexpr (!ALIGN_EPI) { if (wr == 0) PG8_BAR; }
    PG8_BAR;
    if constexpr (Epi::AFTER_DRAIN) { E.fused(acc, cur, wr, wc, fr, fq, lds, wid, lane); S.done(cur); }
#undef PG8_SA
#undef PG8_SB
#undef PG8_STAGE
#undef PG8_LDA
#undef PG8_LDB
#undef PG8_MMA
#undef PG8_WAIT_V
#undef PG8_WAIT_L
#undef PG8_BAR
#undef PG8_SCHED
}
}

constexpr int NWAVES = 8;
constexpr int NB = 8, SEQ = 2048, DM = 2048, M = NB * SEQ;
constexpr int DSGU = 768, DCONV = 768, DMEM = 512, DIN = 4352, DFF = 8192, NMEM = 256, HD = 128, CHUNK = 128;
constexpr int OFF_U = 0, OFF_V = 768, OFF_B = 1536, OFF_C = 2304, OFF_X = 3072, OFF_Q = 3840;
constexpr float EPS = 1e-6f;
constexpr float QSCALE = 0.08838834764831845f * 1.4426950408889634f;
#ifndef MK_N_LAUNCHES
#define MK_N_LAUNCHES 1
#endif
constexpr int N_PHASES = 7;
constexpr int N_LAUNCHES = MK_N_LAUNCHES;

constexpr size_t MiB = 1u << 20;
constexpr size_t WS_CTL = 0, CTL_ZERO_BYTES = 64 * 1024;
constexpr size_t WS_VSTATS = 1 * MiB;
constexpr size_t WS_SSQ1 = 3 * MiB;
constexpr size_t WS_SSQ2 = 5 * MiB;
constexpr size_t WS_WO = 8 * MiB;
constexpr size_t WS_W1 = 16 * MiB;
constexpr size_t WS_W2 = 48 * MiB;
constexpr size_t WS_KMAT = 80 * MiB;
constexpr size_t WS_VT = 82 * MiB;
constexpr size_t WS_BIG = 84 * MiB;
constexpr size_t WS_XN = WS_BIG, WS_MEMN = WS_BIG + 64 * MiB, WS_WIN = WS_BIG + 72 * MiB, WS_WKV = WS_BIG + 89 * MiB;
constexpr size_t WS_X1B = WS_XN;
constexpr size_t WS_PROJ = 180 * MiB;
constexpr size_t WS_HEADS = 316 * MiB;
constexpr size_t WS_HID = 180 * MiB;
constexpr size_t WS_END = 436 * MiB;
constexpr int CW_BAR = 1024;

constexpr int SCRATCH_BYTES = 139264;
constexpr int MISC_OFF = SCRATCH_BYTES;
constexpr int LDS_BYTES = 147456;

#define GAS __attribute__((address_space(1)))
#define LAS __attribute__((address_space(3)))
typedef unsigned short bf16;
typedef unsigned v4u __attribute__((ext_vector_type(4)));
typedef float f32x4 __attribute__((ext_vector_type(4)));
typedef short bf16x8 __attribute__((ext_vector_type(8)));
typedef GAS unsigned gu32;
typedef GAS unsigned long long gu64;
#define RLX_AGENT __ATOMIC_RELAXED, __HIP_MEMORY_SCOPE_AGENT
#define LDS_WAIT() asm volatile("s_waitcnt lgkmcnt(0)" ::: "memory")
#define VM_WAIT() asm volatile("s_waitcnt vmcnt(0)" ::: "memory")
__device__ __forceinline__ unsigned long long rt() { return __builtin_amdgcn_s_memrealtime(); }
__device__ __forceinline__ unsigned f2bf(float f) { unsigned u = __builtin_bit_cast(unsigned, f); return (u + 0x7fffu + ((u >> 16) & 1u)) >> 16; }
__device__ __forceinline__ unsigned pk2(float lo, float hi) { return f2bf(lo) | (f2bf(hi) << 16); }

#define XB_TMO      128
#define XB_XCNT(j)  (256  + 64 * (j))
#define XB_XSUB(j)  (1280 + 64 * (j))
#define XB_XGEN(j)  (2304 + 64 * (j))
#define XB_TOP      3328
#define XB_TOPGEN   3392
#define XCD_BAR_WORDS 3456
#define XB_SPIN_CAP (1u << 18)

__device__ __forceinline__ unsigned xb_ld(unsigned* p)              { return __hip_atomic_load(p, __ATOMIC_RELAXED, __HIP_MEMORY_SCOPE_AGENT); }
__device__ __forceinline__ unsigned xb_add(unsigned* p, unsigned v) { return __hip_atomic_fetch_add(p, v, __ATOMIC_RELAXED, __HIP_MEMORY_SCOPE_AGENT); }
__device__ __forceinline__ unsigned xb_xcc_id() { return (unsigned)__builtin_amdgcn_s_getreg((3 << 11) | 20) & 0xFu; }
#define XB_SPIN(cond, bar) do { unsigned _sp = 0; while (cond) { __builtin_amdgcn_s_sleep(1); \
    if ((++_sp & 255u) == 0u) { if (xb_ld(&(bar)[XB_TMO])) break; if (_sp > XB_SPIN_CAP) { atomicAdd(&(bar)[XB_TMO], 1u); break; } } } } while (0)

struct XcdBarrier {
    unsigned* bar; unsigned x;
    volatile LAS unsigned* st;
};

__device__ __forceinline__ XcdBarrier xcd_barrier_post(unsigned* bar, volatile LAS unsigned* st) {
    XcdBarrier b; b.bar = bar; b.x = xb_xcc_id(); b.st = st;
    if (threadIdx.x == 0) (void)xb_add(&bar[XB_XCNT(b.x)], 1u);
    return b;
}
__device__ __forceinline__ void xcd_barrier_complete(unsigned* bar, unsigned x, unsigned& nloc, unsigned& nx) {
    const unsigned G = gridDim.x * gridDim.y * gridDim.z;
    unsigned sum, cnt, mine, sp = 0u;
    for (;;) {
        sum = 0u; cnt = 0u; mine = 0u;
#pragma unroll
        for (unsigned j = 0; j < 16; ++j) { const unsigned c = xb_ld(&bar[XB_XCNT(j)]); sum += c; cnt += (c > 0u) ? 1u : 0u; mine = (j == x) ? c : mine; }
        if (sum == G) break;
        __builtin_amdgcn_s_sleep(1);
        if ((++sp & 255u) == 0u) { if (xb_ld(&bar[XB_TMO])) break; if (sp > XB_SPIN_CAP) { atomicAdd(&bar[XB_TMO], 1u); break; } }
    }
    nloc = mine > 0u ? mine : 1u; nx = cnt > 0u ? cnt : 1u;
}

__device__ __forceinline__ void xcd_barrier(const XcdBarrier& b) {
    asm volatile("s_waitcnt vmcnt(0)" ::: "memory");
    __syncthreads();
    if (threadIdx.x == 0) {
        unsigned* bar = b.bar;
        __builtin_amdgcn_s_waitcnt(0);
        unsigned nloc = b.st[0], nx = b.st[1];
        if (nloc == 0u) { xcd_barrier_complete(bar, b.x, nloc, nx); b.st[0] = nloc; b.st[1] = nx; }
        const unsigned old = xb_add(&bar[XB_XSUB(b.x)], 1u);
        const unsigned gen = old / nloc;
        if (old + 1u == (gen + 1u) * nloc) {
            __builtin_amdgcn_fence(__ATOMIC_RELEASE, "agent");
            asm volatile("s_waitcnt vmcnt(0)" ::: "memory");
            const unsigned og = xb_add(&bar[XB_TOP], 1u);
            const unsigned tg = og / nx;
            if (og + 1u == (tg + 1u) * nx) xb_add(&bar[XB_TOPGEN], 1u);
            else XB_SPIN(xb_ld(&bar[XB_TOPGEN]) == tg, bar);
            __builtin_amdgcn_fence(__ATOMIC_ACQUIRE, "agent");
            xb_add(&bar[XB_XGEN(b.x)], 1u);
            asm volatile("s_waitcnt vmcnt(0)" ::: "memory");
        } else {
            XB_SPIN(xb_ld(&bar[XB_XGEN(b.x)]) == gen, bar);
            __builtin_amdgcn_fence(__ATOMIC_ACQUIRE, "agent");
            asm volatile("s_waitcnt vmcnt(0)" ::: "memory");
        }
    }
    __syncthreads();
}

typedef unsigned v2u __attribute__((ext_vector_type(2)));
typedef float f32x2 __attribute__((ext_vector_type(2)));
typedef short bf16x4 __attribute__((ext_vector_type(4)));
__device__ __forceinline__ float bflo(unsigned u) { return __builtin_bit_cast(float, u << 16); }
__device__ __forceinline__ float bfhi(unsigned u) { return __builtin_bit_cast(float, u & 0xffff0000u); }
__device__ __forceinline__ void unpack8(const v4u w, float (&f)[8]) { f[0] = bflo(w.x); f[1] = bfhi(w.x); f[2] = bflo(w.y); f[3] = bfhi(w.y); f[4] = bflo(w.z); f[5] = bfhi(w.z); f[6] = bflo(w.w); f[7] = bfhi(w.w); }


struct Args {
    const float *x, *mem, *g_mix, *w_in, *ln_g, *ln_b, *w_s, *b_s, *conv_w, *g_mem, *w_kv, *g_head, *w_o, *g_ffn, *w1, *w2, *g_final;
    float* out; unsigned char* ws; int ph_lo, ph_hi;
};

__device__ __forceinline__ float wave_sum(float v) {
#pragma unroll
    for (int o = 1; o < 64; o <<= 1) v += __shfl_xor(v, o);
    return v;
}
__device__ __forceinline__ void p0_transpose_item(const float* W, int K, int N, bf16* WT, const float* ks, LAS float* scr, int item, int lane) {
    const int nblk = N / 32, kb = item / nblk, nb = item % nblk, k0 = 64 * kb, n0 = 32 * nb;
#pragma unroll 8
    for (int i = 0; i < 32; ++i) { const int kk = 2 * i + (lane >> 5); float w = W[(size_t)(k0 + kk) * N + n0 + (lane & 31)]; if (ks) w *= ks[k0 + kk]; scr[kk * 33 + (lane & 31)] = w; }
    LDS_WAIT(); asm volatile("" ::: "memory");
    const int c = lane & 7;
#pragma unroll
    for (int j = 0; j < 4; ++j) { const int n = (lane >> 3) + 8 * j; const LAS float* s = scr + (8 * c) * 33 + n;
        v4u o; o.x = pk2(s[0 * 33], s[1 * 33]); o.y = pk2(s[2 * 33], s[3 * 33]); o.z = pk2(s[4 * 33], s[5 * 33]); o.w = pk2(s[6 * 33], s[7 * 33]);
        *(GAS v4u*)(WT + (size_t)(n0 + n) * K + k0 + 8 * c) = o; }
    LDS_WAIT(); asm volatile("" ::: "memory");
}
__device__ __forceinline__ void rms_row_to_bf16(const float* xrow, const float* gain, bf16* orow, int lane) {
    const GAS f32x4* xr = (const GAS f32x4*)xrow + lane; const GAS f32x4* gr = (const GAS f32x4*)gain + lane;
    f32x4 v[8]; float s = 0.f;
#pragma unroll
    for (int j = 0; j < 8; ++j) { v[j] = xr[64 * j]; s += (v[j].x * v[j].x + v[j].y * v[j].y) + (v[j].z * v[j].z + v[j].w * v[j].w); }
    const float rinv = 1.0f / sqrtf(wave_sum(s) * (1.f / DM) + EPS);
    GAS v2u* o8 = (GAS v2u*)orow + lane;
#pragma unroll
    for (int j = 0; j < 8; ++j) { const f32x4 g = gr[64 * j]; v2u o; o.x = pk2(v[j].x * rinv * g.x, v[j].y * rinv * g.y); o.y = pk2(v[j].z * rinv * g.z, v[j].w * rinv * g.w); o8[64 * j] = o; }
}

__device__ __forceinline__ void head_norm_store(float (&v)[4][8], size_t row, int hcol0, int g, const float* g_head, bf16* heads) {
    float s = 0.f;
#pragma unroll
    for (int p = 0; p < 4; ++p)
#pragma unroll
        for (int e = 0; e < 8; ++e) s += v[p][e] * v[p][e];
    s += __shfl_xor(s, 16); s += __shfl_xor(s, 32);
    const float rinv = 1.0f / sqrtf(s * (1.f / HD) + EPS);
#pragma unroll
    for (int p = 0; p < 4; ++p) {
        const int c = hcol0 + 32 * p + 8 * g;
        const f32x4 g0 = *(const GAS f32x4*)(g_head + c), g1 = *(const GAS f32x4*)(g_head + c + 4);
        v4u w; w.x = pk2(v[p][0] * rinv * g0.x, v[p][1] * rinv * g0.y); w.y = pk2(v[p][2] * rinv * g0.z, v[p][3] * rinv * g0.w);
        w.z = pk2(v[p][4] * rinv * g1.x, v[p][5] * rinv * g1.y); w.w = pk2(v[p][6] * rinv * g1.z, v[p][7] * rinv * g1.w);
        *(GAS v4u*)(heads + row * DM + c) = w;
    }
}

constexpr int VROW = 272;
constexpr int KROW = 272;
constexpr int VTROW = 528;
constexpr int K_BYTES = 256 * KROW;
static_assert(K_BYTES + 128 * VTROW <= SCRATCH_BYTES, "attention tiles fit the scratch");

__device__ __forceinline__ void sgu_unit(const Args& A, LAS unsigned char* lds, int R0, int h, int tid) {
    const bf16* proj = (const bf16*)(A.ws + WS_PROJ); const float* vstats = (const float*)(A.ws + WS_VSTATS); bf16* heads = (bf16*)(A.ws + WS_HEADS);
    const int lane = tid & 63, w = __builtin_amdgcn_readfirstlane(tid >> 6), fr = lane & 15, g = lane >> 4;
    {
        const int sp = tid >> 3, dc = tid & 7, d0 = 16 * dc;
        float mean[2], rstd[2];
#pragma unroll
        for (int r = 0; r < 2; ++r) {
            const GAS f32x4* st = (const GAS f32x4*)(vstats + (size_t)(R0 + 2 * sp + r) * 24);
            float s1 = 0.f, s2 = 0.f;
#pragma unroll
            for (int i = 0; i < 6; ++i) { const f32x4 t = st[i]; s1 += t.x + t.z; s2 += t.y + t.w; }
            mean[r] = s1 * (1.f / DSGU); const float var = s2 * (1.f / DSGU) - mean[r] * mean[r]; rstd[r] = 1.0f / sqrtf(fmaxf(var, 0.f) + EPS);
        }
        float val[2][16];
#pragma unroll
        for (int r = 0; r < 2; ++r) {
            const GAS v4u* src = (const GAS v4u*)(proj + (size_t)(R0 + 2 * sp + r) * DIN + OFF_V + h * HD + d0);
            float f0[8], f1[8]; unpack8(src[0], f0); unpack8(src[1], f1);
#pragma unroll
            for (int e = 0; e < 8; ++e) { val[r][e] = (f0[e] - mean[r]) * rstd[r]; val[r][8 + e] = (f1[e] - mean[r]) * rstd[r]; }
        }
#pragma unroll
        for (int q = 0; q < 4; ++q) {
            const f32x4 lg = *(const GAS f32x4*)(A.ln_g + h * HD + d0 + 4 * q), lb = *(const GAS f32x4*)(A.ln_b + h * HD + d0 + 4 * q);
#pragma unroll
            for (int e = 0; e < 4; ++e) {
                const int i = 4 * q + e;
                const float a = val[0][i] * lg[e] + lb[e], b = val[1][i] * lg[e] + lb[e];
                *(LAS unsigned*)(lds + (d0 + i) * VROW + 4 * sp) = pk2(a, b);
            }
        }
    }
    __syncthreads();
    f32x4 acc[4][2];
#pragma unroll
    for (int p = 0; p < 4; ++p)
#pragma unroll
        for (int q = 0; q < 2; ++q) acc[p][q] = (f32x4){0.f, 0.f, 0.f, 0.f};
    const int t = 16 * w + fr;
    const int nks = (w >> 1) + 1;
    const float* wrow = A.w_s + ((size_t)h * CHUNK + t) * CHUNK;
    for (int ks = 0; ks < nks; ++ks) {
        const int s0 = 32 * ks + 8 * g;
        const f32x4 w0 = *(const GAS f32x4*)(wrow + s0), w1 = *(const GAS f32x4*)(wrow + s0 + 4);
        float wf[8] = {w0.x, w0.y, w0.z, w0.w, w1.x, w1.y, w1.z, w1.w};
#pragma unroll
        for (int e = 0; e < 8; ++e) wf[e] = (s0 + e <= t) ? wf[e] : 0.f;
        v4u bw; bw.x = pk2(wf[0], wf[1]); bw.y = pk2(wf[2], wf[3]); bw.z = pk2(wf[4], wf[5]); bw.w = pk2(wf[6], wf[7]);
        const bf16x8 bfrag = __builtin_bit_cast(bf16x8, bw);
#pragma unroll
        for (int p = 0; p < 4; ++p)
#pragma unroll
            for (int q = 0; q < 2; ++q) {
                const int drow = 32 * p + 8 * (fr >> 2) + 4 * q + (fr & 3);
                const bf16x8 afrag = *(const LAS bf16x8*)(lds + drow * VROW + 64 * ks + 16 * g);
                acc[p][q] = __builtin_amdgcn_mfma_f32_16x16x32_bf16(afrag, bfrag, acc[p][q], 0, 0, 0);
            }
    }
    const float bias = A.b_s[h * CHUNK + t];
    float v[4][8];
#pragma unroll
    for (int p = 0; p < 4; ++p) {
        float gu[8]; unpack8(*(const GAS v4u*)(proj + (size_t)(R0 + t) * DIN + OFF_U + h * HD + 32 * p + 8 * g), gu);
#pragma unroll
        for (int q = 0; q < 2; ++q)
#pragma unroll
            for (int e = 0; e < 4; ++e) v[p][4 * q + e] = gu[4 * q + e] * (acc[p][q][e] + bias);
    }
    head_norm_store(v, (size_t)(R0 + t), h * HD, g, A.g_head, heads);
    __syncthreads();
}

__device__ __forceinline__ void conv_unit(const Args& A, int R0, int tpos0, int grp, int tid) {
    const bf16* proj = (const bf16*)(A.ws + WS_PROJ); bf16* heads = (bf16*)(A.ws + WS_HEADS);
    const int lane = tid & 63, w = tid >> 6, fr = lane & 15, g = lane >> 4;
    const int t = 16 * w + fr; const size_t row = (size_t)(R0 + t); const int tpos = tpos0 + t;
    float v[4][8];
#pragma unroll
    for (int p = 0; p < 4; ++p) {
        const int col = grp * HD + 32 * p + 8 * g;
        float y[8];
#pragma unroll
        for (int e = 0; e < 8; ++e) y[e] = 0.f;
#pragma unroll
        for (int k = 0; k < 3; ++k) {
            const int back = 2 - k;
            if (tpos - back >= 0) {
                float c[8], xin[8];
                unpack8(*(const GAS v4u*)(proj + (row - back) * DIN + OFF_C + col), c);
                unpack8(*(const GAS v4u*)(proj + (row - back) * DIN + OFF_X + col), xin);
                const f32x4 k0 = *(const GAS f32x4*)(A.conv_w + k * DCONV + col), k1 = *(const GAS f32x4*)(A.conv_w + k * DCONV + col + 4);
                const float kw[8] = {k0.x, k0.y, k0.z, k0.w, k1.x, k1.y, k1.z, k1.w};
#pragma unroll
                for (int e = 0; e < 8; ++e) y[e] += kw[e] * (c[e] * xin[e]);
            }
        }
        float bg[8]; unpack8(*(const GAS v4u*)(proj + row * DIN + OFF_B + col), bg);
#pragma unroll
        for (int e = 0; e < 8; ++e) v[p][e] = bg[e] * y[e];
    }
    head_norm_store(v, row, DSGU + grp * HD, g, A.g_head, heads);
}

__device__ __forceinline__ void attn_stage(const Args& A, LAS unsigned char* lds, int b, int h, int tid) {
    const bf16* kmat = (const bf16*)(A.ws + WS_KMAT); const bf16* vt = (const bf16*)(A.ws + WS_VT);
#pragma unroll
    for (int it = 0; it < 8; ++it) {
        const int idx = tid + 512 * it;
        { const int key = idx >> 4, ch = idx & 15; const v4u d = *(const GAS v4u*)(kmat + (size_t)(b * NMEM + key) * DMEM + h * HD + 8 * ch); *(LAS v4u*)(lds + key * KROW + 16 * ch) = d; }
        { const int dd = idx >> 5, ch = idx & 31; const v4u d = *(const GAS v4u*)(vt + (size_t)(h * HD + dd) * (NB * NMEM) + b * NMEM + 8 * ch); *(LAS v4u*)(lds + K_BYTES + dd * VTROW + 16 * ch) = d; }
    }
}
__device__ __forceinline__ void attn_chunk(const Args& A, LAS unsigned char* lds, int R0, int h, int tid) {
    const bf16* proj = (const bf16*)(A.ws + WS_PROJ); bf16* heads = (bf16*)(A.ws + WS_HEADS);
    const int lane = tid & 63, w = tid >> 6, fr = lane & 15, g = lane >> 4;
    const size_t row = (size_t)(R0 + 16 * w + fr);
    bf16x8 qf[4];
#pragma unroll
    for (int ks = 0; ks < 4; ++ks) qf[ks] = __builtin_bit_cast(bf16x8, *(const GAS v4u*)(proj + row * DIN + OFF_Q + h * HD + 32 * ks + 8 * g));
    f32x4 sacc[16];
    bf16x8 kf[2][4];
#pragma unroll
    for (int ks = 0; ks < 4; ++ks) kf[0][ks] = *(const LAS bf16x8*)(lds + fr * KROW + 64 * ks + 16 * g);
#pragma unroll
    for (int kt = 0; kt < 16; ++kt) {
        if (kt + 1 < 16) {
#pragma unroll
            for (int ks = 0; ks < 4; ++ks) kf[(kt + 1) & 1][ks] = *(const LAS bf16x8*)(lds + (16 * (kt + 1) + fr) * KROW + 64 * ks + 16 * g);
        }
        sacc[kt] = (f32x4){0.f, 0.f, 0.f, 0.f};
#pragma unroll
        for (int ks = 0; ks < 4; ++ks) sacc[kt] = __builtin_amdgcn_mfma_f32_16x16x32_bf16(kf[kt & 1][ks], qf[ks], sacc[kt], 0, 0, 0);
        asm volatile("" ::: "memory");
    }
    float mx = -3.0e38f;
#pragma unroll
    for (int kt = 0; kt < 16; ++kt) mx = fmaxf(mx, fmaxf(fmaxf(sacc[kt][0], sacc[kt][1]), fmaxf(sacc[kt][2], sacc[kt][3])));
    mx = fmaxf(mx, __shfl_xor(mx, 16)); mx = fmaxf(mx, __shfl_xor(mx, 32));
    float l = 0.f;
#pragma unroll
    for (int kt = 0; kt < 16; ++kt)
#pragma unroll
        for (int e = 0; e < 4; ++e) { const float p = __builtin_amdgcn_exp2f(sacc[kt][e] - mx); sacc[kt][e] = p; l += p; }
    l += __shfl_xor(l, 16); l += __shfl_xor(l, 32);
    f32x4 oacc[4][2];
#pragma unroll
    for (int p = 0; p < 4; ++p)
#pragma unroll
        for (int q = 0; q < 2; ++q) oacc[p][q] = (f32x4){0.f, 0.f, 0.f, 0.f};
    v4u af[2][4][2];
    const LAS unsigned char* vbase = lds + K_BYTES + (8 * (fr >> 2) + (fr & 3)) * VTROW + 8 * g;
#define LOAD_AF(buf, s_) do { _Pragma("unroll") for (int p = 0; p < 4; ++p) _Pragma("unroll") for (int q = 0; q < 2; ++q) { \
        const LAS unsigned char* a0 = vbase + (32 * p + 4 * q) * VTROW + 64 * (s_); const v2u lo_ = *(const LAS v2u*)a0, hi_ = *(const LAS v2u*)(a0 + 32); \
        af[buf][p][q] = (v4u){lo_.x, lo_.y, hi_.x, hi_.y}; } } while (0)
    LOAD_AF(0, 0);
#pragma unroll
    for (int s = 0; s < 8; ++s) {
        if (s + 1 < 8) LOAD_AF((s + 1) & 1, s + 1);
        v4u pw; pw.x = pk2(sacc[2 * s][0], sacc[2 * s][1]); pw.y = pk2(sacc[2 * s][2], sacc[2 * s][3]); pw.z = pk2(sacc[2 * s + 1][0], sacc[2 * s + 1][1]); pw.w = pk2(sacc[2 * s + 1][2], sacc[2 * s + 1][3]);
        const bf16x8 pf = __builtin_bit_cast(bf16x8, pw);
#pragma unroll
        for (int p = 0; p < 4; ++p)
#pragma unroll
            for (int q = 0; q < 2; ++q)
                oacc[p][q] = __builtin_amdgcn_mfma_f32_16x16x32_bf16(__builtin_bit_cast(bf16x8, af[s & 1][p][q]), pf, oacc[p][q], 0, 0, 0);
        asm volatile("" ::: "memory");
    }
#undef LOAD_AF
    const float linv = 1.0f / l;
    float v[4][8];
#pragma unroll
    for (int p = 0; p < 4; ++p)
#pragma unroll
        for (int q = 0; q < 2; ++q)
#pragma unroll
            for (int e = 0; e < 4; ++e) v[p][4 * q + e] = oacc[p][q][e] * linv;
    head_norm_store(v, row, DSGU + DCONV + h * HD, g, A.g_head, heads);
}

__global__ void __launch_bounds__(NWAVES * 64, 2) fwd_kernel(Args args) {
    extern __shared__ __attribute__((aligned(16))) unsigned char lds_raw[];
    LAS unsigned char* lds = (LAS unsigned char*)lds_raw;
    volatile LAS unsigned* MISC = (volatile LAS unsigned*)(lds + MISC_OFF);
    const int tid = threadIdx.x, lane = tid & 63, wave = __builtin_amdgcn_readfirstlane(tid >> 6);
    const int G = gridDim.x, bx = blockIdx.x;
    const int vcu = (G % 8 == 0) ? (bx % 8) * (G / 8) + bx / 8 : bx;
    unsigned char* ws = args.ws;
    for (int u = tid; u < (LDS_BYTES - MISC_OFF) / 4; u += NWAVES * 64) ((LAS unsigned*)(lds + MISC_OFF))[u] = 0u;
    __syncthreads();
    XcdBarrier bar; bar.bar = (unsigned*)(ws + WS_CTL) + CW_BAR; bar.x = 0; bar.st = nullptr;
    if (N_LAUNCHES == 1) bar = xcd_barrier_post((unsigned*)(ws + WS_CTL) + CW_BAR, MISC + 8);
    const int lo = args.ph_lo, hi = args.ph_hi;
#define IN(k) (lo <= (k) && (k) < hi)
#define SEAM(k) do { if (IN(k) && IN((k) + 1)) xcd_barrier(bar); } while (0)
    bf16* BIG = (bf16*)(ws + WS_BIG);

    if (IN(0)) {
        LAS float* scr = (LAS float*)(lds + wave * 16384);
        const int gw = vcu * NWAVES + wave, NGW = G * NWAVES;
        constexpr int I_IN = (DM / 64) * (DIN / 32), I_KV = (DM / 64) * (2 * DMEM / 32), I_O = (DM / 64) * (DM / 32), I_1 = (DM / 64) * (DFF / 32), I_2 = (DFF / 64) * (DM / 32);
        constexpr int NITEMS = I_IN + I_KV + I_O + I_1 + I_2;
        for (int it = gw; it < NITEMS; it += NGW) {
            int r = it;
            if (r < I_IN) { p0_transpose_item(args.w_in, DM, DIN, (bf16*)(ws + WS_WIN), nullptr, scr, r, lane); continue; } r -= I_IN;
            if (r < I_KV) { p0_transpose_item(args.w_kv, DM, 2 * DMEM, (bf16*)(ws + WS_WKV), nullptr, scr, r, lane); continue; } r -= I_KV;
            if (r < I_O) { p0_transpose_item(args.w_o, DM, DM, (bf16*)(ws + WS_WO), nullptr, scr, r, lane); continue; } r -= I_O;
            if (r < I_1) { p0_transpose_item(args.w1, DM, DFF, (bf16*)(ws + WS_W1), args.g_ffn, scr, r, lane); continue; } r -= I_1;
            p0_transpose_item(args.w2, DFF, DM, (bf16*)(ws + WS_W2), nullptr, scr, r, lane);
        }
        for (int m = gw; m < M + NB * NMEM; m += NGW) {
            if (m < M) rms_row_to_bf16(args.x + (size_t)m * DM, args.g_mix, (bf16*)(ws + WS_XN) + (size_t)m * DM, lane);
            else rms_row_to_bf16(args.mem + (size_t)(m - M) * DM, args.g_mem, (bf16*)(ws + WS_MEMN) + (size_t)(m - M) * DM, lane);
        }
    }
    SEAM(0);
    if (IN(1)) {
        pg8::Gemm g{BIG, BIG, 0, 0, DM}; pg8::Order1 S; S.init(G, bx);
        pg8::Epi1 E{(bf16*)(ws + WS_PROJ), (bf16*)(ws + WS_KMAT), (bf16*)(ws + WS_VT), (float*)(ws + WS_VSTATS), QSCALE};
        pg8::gemm_phase<pg8::Epi1, pg8::Order1, true, true>(lds, g, S, E);
    }
    SEAM(1);
    if (IN(2)) {
        for (int s = bx; s < 768; s += G) { const int h = s % 6, bc = s / 6; sgu_unit(args, lds, bc * CHUNK, h, tid); }
        for (int s = bx; s < 768; s += G) { const int grp = s % 6, bc = s / 6; conv_unit(args, bc * CHUNK, (bc & 15) * CHUNK, grp, tid); }
        for (int a = vcu; a < 256; a += G) {
            const int bh = a >> 3, cp = a & 7, b = bh >> 2, h = bh & 3;
            attn_stage(args, lds, b, h, tid);
            __syncthreads();
#pragma unroll 1
            for (int r = 0; r < 2; ++r) attn_chunk(args, lds, b * SEQ + (cp + 8 * r) * CHUNK, h, tid);
            __syncthreads();
        }
    }
    SEAM(2);
    if (IN(3)) {
        pg8::Gemm g{(const bf16*)(ws + WS_HEADS), (const bf16*)(ws + WS_WO), M, DM, DM}; pg8::StaticOrder S; S.init(M, DM, G, bx);
        pg8::Epi3 E{args.x, args.out, (bf16*)(ws + WS_X1B), (float*)(ws + WS_SSQ1)};
        pg8::gemm_phase<pg8::Epi3, pg8::StaticOrder, true, true>(lds, g, S, E);
    }
    SEAM(3);
    if (IN(4)) {
        pg8::Gemm g{(const bf16*)(ws + WS_X1B), (const bf16*)(ws + WS_W1), M, DFF, DM}; pg8::StaticOrder S; S.init(M, DFF, G, bx);
        pg8::Epi4 E{(bf16*)(ws + WS_HID), (const float*)(ws + WS_SSQ1)};
        pg8::gemm_phase<pg8::Epi4, pg8::StaticOrder, true, true>(lds, g, S, E);
    }
    SEAM(4);
    if (IN(5)) {
        pg8::Gemm g{(const bf16*)(ws + WS_HID), (const bf16*)(ws + WS_W2), M, DM, DFF}; pg8::StaticOrder S; S.init(M, DM, G, bx);
        pg8::Epi5 E{args.out, (float*)(ws + WS_SSQ2)};
        pg8::gemm_phase<pg8::Epi5, pg8::StaticOrder, true, true>(lds, g, S, E);
    }
    SEAM(5);
    if (IN(6)) {
        const int gw = bx * NWAVES + wave, NGW = G * NWAVES;
        const float* ssq2 = (const float*)(ws + WS_SSQ2);
        for (int m = gw; m < M; m += NGW) {
            const float part = lane < 32 ? ssq2[(size_t)m * 32 + lane] : 0.f;
            const float rinv = 1.0f / sqrtf(wave_sum(part) * (1.f / DM) + EPS);
            GAS f32x4* xr = (GAS f32x4*)(args.out + (size_t)m * DM) + lane; const GAS f32x4* gr = (const GAS f32x4*)args.g_final + lane;
            f32x4 v[8];
#pragma unroll
            for (int j = 0; j < 8; ++j) v[j] = xr[64 * j];
#pragma unroll
            for (int j = 0; j < 8; ++j) xr[64 * j] = v[j] * rinv * gr[64 * j];
        }
    }
#undef IN
#undef SEAM
}

extern "C" void kernel_launch(void* const* d_in, const int* in_sizes, int n_in, void* d_out, int out_size, void* d_ws, size_t ws_size, hipStream_t stream) {
    static int grid = 0;
    if (grid == 0) {
        if (n_in != 17 || in_sizes[0] != M * DM || out_size != M * DM || ws_size < WS_END) { fprintf(stderr, "kernel_launch: unexpected shapes (n_in %d, in0 %d, out %d, ws %zu); nothing launched\n", n_in, n_in > 0 ? in_sizes[0] : -1, out_size, ws_size); grid = -1; return; }
        int dev = 0, cus = 0, per_cu = 0;
        if (hipGetDevice(&dev) != hipSuccess || hipDeviceGetAttribute(&cus, hipDeviceAttributeMultiprocessorCount, dev) != hipSuccess) { grid = -1; return; }
        if (hipFuncSetAttribute((const void*)fwd_kernel, hipFuncAttributeMaxDynamicSharedMemorySize, LDS_BYTES) != hipSuccess) { fprintf(stderr, "kernel_launch: hipFuncSetAttribute failed\n"); grid = -1; return; }
        if (hipOccupancyMaxActiveBlocksPerMultiprocessor(&per_cu, (const void*)fwd_kernel, NWAVES * 64, LDS_BYTES) != hipSuccess || per_cu < 1) { fprintf(stderr, "kernel_launch: occupancy query says %d blocks per CU\n", per_cu); (void)hipGetLastError(); grid = -1; return; }
        grid = cus;
    }
    if (grid < 0) return;
    (void)hipMemsetAsync((char*)d_ws + WS_CTL, 0, CTL_ZERO_BYTES, stream);
    Args a{};
    const float** p = (const float**)&a;
    for (int i = 0; i < 17; ++i) p[i] = (const float*)d_in[i];
    a.out = (float*)d_out; a.ws = (unsigned char*)d_ws;
    for (int li = 0; li < N_LAUNCHES; ++li) {
        a.ph_lo = (N_LAUNCHES == 1) ? 0 : li; a.ph_hi = (N_LAUNCHES == 1) ? N_PHASES : li + 1;
        hipLaunchKernelGGL(fwd_kernel, dim3(grid), dim3(NWAVES * 64), LDS_BYTES, stream, a);
        const hipError_t le = hipPeekAtLastError();
        if (le != hipSuccess) { fprintf(stderr, "kernel_launch: launch %d failed: %s\n", li, hipGetErrorName(le)); break; }
    }
}
```

```cpp
#include <hip/hip_runtime.h>
#include <cstdio>
#include <cstdint>
namespace pg8 {
#define PG8_LAS __attribute__((address_space(3)))
typedef unsigned short bf16_t;
typedef short bf16x8 __attribute__((ext_vector_type(8)));
typedef float f32x4 __attribute__((ext_vector_type(4)));
typedef unsigned u32x4 __attribute__((ext_vector_type(4)));
constexpr int BM = 256, BK = 64, HALF = 128, HTB = HALF * BK * 2  , STAGE_BYTES = 8 * HTB, NXCD = 8, WGM = 8;

__host__ __device__ __forceinline__ int lds_byte(int r, int c) { const int st = (r >> 4) * 2 + (c >> 5), rr = r & 15, cc = c & 31, ob = rr * 64 + cc * 2; return st * 1024 + (ob ^ (((ob >> 9) & 1) << 5)); }
__host__ __device__ __forceinline__ void stage_rc(int b, int& R, int& C) { const int st = b / 1024, sb = b % 1024, swz = sb ^ (((sb >> 9) & 1) << 5); R = (st >> 1) * 16 + swz / 64; C = (st & 1) * 32 + (swz % 64) / 2; }
__host__ __device__ __forceinline__ int perm32(int rho) { const int n = rho >> 4, i = rho & 15; return 8 * (i >> 2) + 4 * n + (i & 3); }

struct Unit { int pm, pn; };
struct Gemm { const bf16_t* A; const bf16_t* Bt; int M, N, K; };

struct StaticOrder {
    int nM, nN, nwg, G, c;
    __host__ __device__ void init(int M, int N, int G_, int c_) { nM = M / BM; nN = N / BM; nwg = nM * nN; G = G_; c = c_; }
    __host__ __device__ bool next(int i, Unit& u) const {
        const long L = (long)i * G + c; if (L >= nwg) return false;
        int wgid = (int)L; { const int q = nwg / NXCD, r = nwg % NXCD, xcd = wgid % NXCD, off = wgid / NXCD; wgid = (xcd < r ? xcd * (q + 1) : r * (q + 1) + (xcd - r) * q) + off; }
        const int nig = WGM * nN, gid = wgid / nig, fm = gid * WGM, gsz = (nM - fm) < WGM ? (nM - fm) : WGM;
        u.pm = fm + ((wgid % nig) % gsz); u.pn = (wgid % nig) / gsz; return true;
    }
    __device__ __forceinline__ void a_ready(const Unit&) const {}
    __device__ __forceinline__ void done(const Unit&) const {}
};

__device__ __forceinline__ unsigned cvt_pk_bf16(float lo, float hi) { unsigned r; asm volatile("v_cvt_pk_bf16_f32 %0, %1, %2" : "=v"(r) : "v"(lo), "v"(hi)); return r; }
typedef float f32x2 __attribute__((ext_vector_type(2)));
typedef unsigned u32x2 __attribute__((ext_vector_type(2)));
__device__ __forceinline__ float gelu_t(float x) {
    const float t = x * (2.302208198f + 0.1029432397f * x * x);
    return x * __builtin_amdgcn_rcpf(1.0f + __builtin_amdgcn_exp2f(-t));
}
constexpr int E_DIN = 4352, E_DM = 2048, E_DFF = 8192;
constexpr float E_EPS = 1e-6f;
constexpr int PAN_MEMN = 64, PAN_WIN = 72, PAN_WKV = 89;

struct Order1 {
    StaticOrder so; int G, c;
    __device__ void init(int G_, int c_) { so.init(16384, E_DIN, G_, c_); G = G_; c = c_; }
    __device__ bool next(int i, Unit& u) const {
        const int L = i * G + c;
        if (L < 1088) { Unit t; so.next(i, t); u.pm = t.pm; u.pn = PAN_WIN + t.pn; return true; }
        const int r = L - 1088;
        if (r < 16) { u.pm = PAN_MEMN + (r & 7); u.pn = PAN_WKV + (r >> 3); return true; }
        if (r < 32) { const int q = r - 16; u.pm = PAN_WKV + 2 + (q >> 3); u.pn = PAN_MEMN + (q & 7); return true; }
        return false;
    }
    __device__ __forceinline__ void a_ready(const Unit&) const {}
    __device__ __forceinline__ void done(const Unit&) const {}
};

struct Epi1 {
    static constexpr bool PERM = true, AFTER_DRAIN = false;
    bf16_t* proj; bf16_t* kmat; bf16_t* vt; float* vstats; float qscale;
    __device__ __forceinline__ void operator()(const f32x4 (&acc)[2][2][4][2], const Unit& u, int wr, int wc, int fr, int fq) const {
        bf16_t* base; int ld, mode, rowt, colt, j = 0;
        const int pa = u.pm, pb = u.pn;
        if (pb >= PAN_WIN && pb < PAN_WKV) { j = pb - PAN_WIN; base = proj; ld = E_DIN; rowt = pa * 256; colt = j * 256; mode = j < 3 ? 1 : (j < 6 ? 2 : (j >= 15 ? 3 : 0)); }
        else if (pb >= PAN_WKV) { base = kmat; ld = 512; rowt = (pa - PAN_MEMN) * 256; colt = (pb - PAN_WKV) * 256; mode = 0; }
        else { base = vt; ld = 2048; rowt = (pa - PAN_WKV - 2) * 256; colt = (pb - PAN_MEMN) * 256; mode = 0; }
        const int row0 = rowt + wr * 64 + fr, col0 = colt + wc * 32 + 8 * fq;
        const float sc = mode == 3 ? qscale : 1.0f;
#pragma unroll
        for (int ai = 0; ai < 2; ++ai)
#pragma unroll
            for (int m = 0; m < 4; ++m) {
                const int row = row0 + ai * HALF + m * 16;
                bf16_t* rowp = base + (size_t)row * ld + col0;
                float s1 = 0.f, s2 = 0.f;
#pragma unroll
                for (int bj = 0; bj < 2; ++bj) {
                    f32x4 v0 = acc[ai][bj][m][0], v1 = acc[ai][bj][m][1];
                    if (mode == 1 || mode == 2) {
#pragma unroll
                        for (int e = 0; e < 4; ++e) { v0[e] = gelu_t(v0[e]); v1[e] = gelu_t(v1[e]); }
                        if (mode == 2) {
#pragma unroll
                            for (int e = 0; e < 4; ++e) { s1 += v0[e] + v1[e]; s2 += v0[e] * v0[e] + v1[e] * v1[e]; }
                        }
                    } else { v0 = v0 * sc; v1 = v1 * sc; }
                    u32x4 w; w.x = cvt_pk_bf16(v0[0], v0[1]); w.y = cvt_pk_bf16(v0[2], v0[3]); w.z = cvt_pk_bf16(v1[0], v1[1]); w.w = cvt_pk_bf16(v1[2], v1[3]);
                    *(u32x4*)(rowp + bj * HALF) = w;
                }
                if (mode == 2) {
                    s1 += __shfl_xor(s1, 16); s1 += __shfl_xor(s1, 32); s2 += __shfl_xor(s2, 16); s2 += __shfl_xor(s2, 32);
                    if (fq == 0) *(f32x2*)(vstats + ((size_t)row * 12 + (j - 3) * 4 + wc) * 2) = (f32x2){s1, s2};
                }
            }
    }
};
struct Epi3 {
    static constexpr bool PERM = true, AFTER_DRAIN = false;
    const float* x; bf16_t* x1b; float* ssq;
    __device__ __forceinline__ void operator()(const f32x4 (&acc)[2][2][4][2], const Unit& u, int wr, int wc, int fr, int fq) const {
        const int row0 = u.pm * BM + wr * 64 + fr, col0 = u.pn * BM + wc * 32 + 8 * fq;
#pragma unroll
        for (int ai = 0; ai < 2; ++ai)
#pragma unroll
            for (int m = 0; m < 4; ++m) {
                const int row = row0 + ai * HALF + m * 16; const size_t off = (size_t)row * E_DM + col0; float s = 0.f;
#pragma unroll
                for (int bj = 0; bj < 2; ++bj) {
                    const f32x4 o0 = *(const f32x4*)(x + off + bj * HALF) + acc[ai][bj][m][0], o1 = *(const f32x4*)(x + off + bj * HALF + 4) + acc[ai][bj][m][1];
                    s += ((o0[0] * o0[0] + o0[1] * o0[1]) + (o0[2] * o0[2] + o0[3] * o0[3])) + ((o1[0] * o1[0] + o1[1] * o1[1]) + (o1[2] * o1[2] + o1[3] * o1[3]));
                    u32x4 w; w.x = cvt_pk_bf16(o0[0], o0[1]); w.y = cvt_pk_bf16(o0[2], o0[3]); w.z = cvt_pk_bf16(o1[0], o1[1]); w.w = cvt_pk_bf16(o1[2], o1[3]);
                    *(u32x4*)(x1b + off + bj * HALF) = w;
                }
                s += __shfl_xor(s, 16); s += __shfl_xor(s, 32);
                if (fq == 0) ssq[(size_t)row * 32 + u.pn * 4 + wc] = s;
            }
    }
};
struct Epi4 {
    static constexpr bool PERM = true, AFTER_DRAIN = false;
    bf16_t* hid; const float* ssq;
    __device__ __forceinline__ void operator()(const f32x4 (&acc)[2][2][4][2], const Unit& u, int wr, int wc, int fr, int fq) const {
        const int row0 = u.pm * BM + wr * 64 + fr, col0 = u.pn * BM + wc * 32 + 8 * fq;
#pragma unroll
        for (int ai = 0; ai < 2; ++ai)
#pragma unroll
            for (int m = 0; m < 4; ++m) {
                const int row = row0 + ai * HALF + m * 16;
                const f32x4 p0 = *(const f32x4*)(ssq + (size_t)row * 32 + 8 * fq), p1 = *(const f32x4*)(ssq + (size_t)row * 32 + 8 * fq + 4);
                float s = ((p0[0] + p0[1]) + (p0[2] + p0[3])) + ((p1[0] + p1[1]) + (p1[2] + p1[3]));
                s += __shfl_xor(s, 16); s += __shfl_xor(s, 32);
                const float rinv = __builtin_amdgcn_rsqf(s * (1.0f / E_DM) + E_EPS);
                bf16_t* rowp = hid + (size_t)row * E_DFF + col0;
#pragma unroll
                for (int bj = 0; bj < 2; ++bj) {
                    f32x4 v0 = acc[ai][bj][m][0] * rinv, v1 = acc[ai][bj][m][1] * rinv;
#pragma unroll
                    for (int e = 0; e < 4; ++e) { const float a = fmaxf(v0[e], 0.f), b = fmaxf(v1[e], 0.f); v0[e] = a * a; v1[e] = b * b; }
                    u32x4 w; w.x = cvt_pk_bf16(v0[0], v0[1]); w.y = cvt_pk_bf16(v0[2], v0[3]); w.z = cvt_pk_bf16(v1[0], v1[1]); w.w = cvt_pk_bf16(v1[2], v1[3]);
                    *(u32x4*)(rowp + bj * HALF) = w;
                }
            }
    }
};
__device__ __forceinline__ float bf_lo(unsigned u) { return __builtin_bit_cast(float, u << 16); }
__device__ __forceinline__ float bf_hi(unsigned u) { return __builtin_bit_cast(float, u & 0xffff0000u); }
struct Epi5 {
    static constexpr bool PERM = true, AFTER_DRAIN = false;
    bf16_t* x1b; float* ssq;
    __device__ __forceinline__ void operator()(const f32x4 (&acc)[2][2][4][2], const Unit& u, int wr, int wc, int fr, int fq) const {
        const int row0 = u.pm * BM + wr * 64 + fr, col0 = u.pn * BM + wc * 32 + 8 * fq;
#pragma unroll
        for (int ai = 0; ai < 2; ++ai)
#pragma unroll
            for (int m = 0; m < 4; ++m) {
                const int row = row0 + ai * HALF + m * 16; const size_t off = (size_t)row * E_DM + col0; float s = 0.f;
#pragma unroll
                for (int bj = 0; bj < 2; ++bj) {
                    const u32x4 xi = *(const u32x4*)(x1b + off + bj * HALF);
                    const f32x4 o0 = (f32x4){bf_lo(xi.x), bf_hi(xi.x), bf_lo(xi.y), bf_hi(xi.y)} + acc[ai][bj][m][0], o1 = (f32x4){bf_lo(xi.z), bf_hi(xi.z), bf_lo(xi.w), bf_hi(xi.w)} + acc[ai][bj][m][1];
                    s += ((o0[0] * o0[0] + o0[1] * o0[1]) + (o0[2] * o0[2] + o0[3] * o0[3])) + ((o1[0] * o1[0] + o1[1] * o1[1]) + (o1[2] * o1[2] + o1[3] * o1[3]));
                    u32x4 w; w.x = cvt_pk_bf16(o0[0], o0[1]); w.y = cvt_pk_bf16(o0[2], o0[3]); w.z = cvt_pk_bf16(o1[0], o1[1]); w.w = cvt_pk_bf16(o1[2], o1[3]);
                    *(u32x4*)(x1b + off + bj * HALF) = w;
                }
                s += __shfl_xor(s, 16); s += __shfl_xor(s, 32);
                if (fq == 0) ssq[(size_t)row * 32 + u.pn * 4 + wc] = s;
            }
    }
};

template <class Epi, class Sched, bool ALIGN_EPI = false, bool SP2 = false>
__device__ __forceinline__ void gemm_phase(PG8_LAS unsigned char* lds, const Gemm g, const Sched& S, const Epi& E) {
    const int tid = threadIdx.x, wid = __builtin_amdgcn_readfirstlane(tid >> 6), lane = tid & 63, wr = wid >> 2, wc = wid & 3, fr = lane & 15, fq = lane >> 4;
    const int K = g.K, nt = K / BK;
    unsigned voffA[2], voffB[2];
#pragma unroll
    for (int i = 0; i < 2; ++i) { int R, C; stage_rc(tid * 16 + i * 8192, R, C); const int Rb = Epi::PERM ? ((R & ~31) + perm32(R & 31)) : R;
        voffA[i] = (unsigned)(R * K + C) * 2u; voffB[i] = (unsigned)(Rb * K + C) * 2u; }
    const size_t kstep = (size_t)(BK * 2);
    const size_t hstep = (size_t)HALF * K * 2;
    const size_t tstep = 2 * hstep;
    const unsigned ldsw = (unsigned)wid * 1024u;
    const int aoff = lds_byte(wr * 64 + fr, fq * 8), boff = lds_byte(wc * 32 + fr, fq * 8);
#define PG8_SA(b, h) (((b) * 2 + (h)) * HTB)
#define PG8_SB(b, h) ((4 + (b) * 2 + (h)) * HTB)
#define PG8_STAGE(bufoff, gbase, voff) do { _Pragma("unroll") for (int _i = 0; _i < 2; ++_i) \
        __builtin_amdgcn_global_load_lds((const unsigned*)((const char*)(gbase) + (voff)[_i]), (PG8_LAS unsigned*)(lds + (bufoff) + ldsw + _i * 8192), 16, 0, 0); } while (0)
#define PG8_LDA(dst, b, h) do { _Pragma("unroll") for (int m = 0; m < 4; ++m) _Pragma("unroll") for (int k = 0; k < 2; ++k) dst[m][k] = *(const PG8_LAS bf16x8*)(lds + PG8_SA(b, h) + aoff + m * 2048 + k * 1024); } while (0)
#define PG8_LDB(dst, b, h) do { _Pragma("unroll") for (int n = 0; n < 2; ++n) _Pragma("unroll") for (int k = 0; k < 2; ++k) dst[n][k] = *(const PG8_LAS bf16x8*)(lds + PG8_SB(b, h) + boff + n * 2048 + k * 1024); } while (0)
#define PG8_MMA(ai, bj, At, Bt) do { __builtin_amdgcn_s_setprio(1); _Pragma("unroll") for (int m = 0; m < 4; ++m) _Pragma("unroll") for (int n = 0; n < 2; ++n) _Pragma("unroll") for (int k = 0; k < 2; ++k) \
        acc[ai][bj][m][n] = __builtin_amdgcn_mfma_f32_16x16x32_bf16(Bt[n][k], At[m][k], acc[ai][bj][m][n], 0, 0, 0); __builtin_amdgcn_s_setprio(0); } while (0)
#define PG8_WAIT_V(n) asm volatile("s_waitcnt vmcnt(" #n ")" ::: "memory")
#define PG8_WAIT_L(n) asm volatile("s_waitcnt lgkmcnt(" #n ")" ::: "memory")
#define PG8_BAR __builtin_amdgcn_s_barrier()
#define PG8_SCHED __builtin_amdgcn_sched_barrier(0)
    Unit cur, nxt; int ui = 0;
    if (!S.next(0, cur)) return;
    f32x4 acc[2][2][4][2];
#pragma unroll
    for (int a = 0; a < 2; ++a)
#pragma unroll
        for (int b = 0; b < 2; ++b)
#pragma unroll
            for (int m = 0; m < 4; ++m)
#pragma unroll
                for (int n = 0; n < 2; ++n) acc[a][b][m][n] = (f32x4){0.f, 0.f, 0.f, 0.f};
    bf16x8 At[4][2], B0[2][2], B1[2][2];
    const char* cA = (const char*)g.A + (size_t)cur.pm * tstep; const char* cB = (const char*)g.Bt + (size_t)cur.pn * tstep;
    S.a_ready(cur);
    if constexpr (SP2) {
        PG8_STAGE(PG8_SB(0, 0), cB, voffB); PG8_STAGE(PG8_SB(0, 1), cB + hstep, voffB); PG8_STAGE(PG8_SA(0, 0), cA, voffA); PG8_STAGE(PG8_SA(0, 1), cA + hstep, voffA);
        if (wr == 1) PG8_BAR;
        PG8_WAIT_V(2); PG8_BAR;
        PG8_STAGE(PG8_SB(1, 0), cB + kstep, voffB); PG8_STAGE(PG8_SA(1, 0), cA + kstep, voffA); PG8_STAGE(PG8_SB(1, 1), cB + hstep + kstep, voffB);
        PG8_WAIT_V(6); PG8_BAR;
    } else {
        PG8_STAGE(PG8_SB(0, 0), cB, voffB); PG8_STAGE(PG8_SA(0, 0), cA, voffA); PG8_STAGE(PG8_SB(0, 1), cB + hstep, voffB); PG8_STAGE(PG8_SA(0, 1), cA + hstep, voffA);
        if (wr == 1) PG8_BAR;
        PG8_WAIT_V(4); PG8_BAR;
        PG8_STAGE(PG8_SB(1, 0), cB + kstep, voffB); PG8_STAGE(PG8_SA(1, 0), cA + kstep, voffA); PG8_STAGE(PG8_SB(1, 1), cB + hstep + kstep, voffB);
        PG8_WAIT_V(6); PG8_BAR;
    }
    for (;;) {
        const bool has_next = S.next(ui + 1, nxt);
        const char* nA = has_next ? (const char*)g.A + (size_t)nxt.pm * tstep : cA; const char* nB = has_next ? (const char*)g.Bt + (size_t)nxt.pn * tstep : cB;
        for (int t = 0; t < nt; t += 2) {
            const bool last = (t == nt - 2);
            const char* a1 = cA + (size_t)(t + 1) * kstep;
            const char* a2 = last ? nA : cA + (size_t)(t + 2) * kstep; const char* b2 = last ? nB : cB + (size_t)(t + 2) * kstep;
            const char* a3 = a2 + kstep; const char* b3 = b2 + kstep;
            if (last && has_next) S.a_ready(nxt);
            if constexpr (SP2) {
            PG8_LDB(B0, 0, 0); PG8_LDB(B1, 0, 1); PG8_SCHED; PG8_LDA(At, 0, 0); PG8_STAGE(PG8_SA(1, 1), a1 + hstep, voffA);
            PG8_WAIT_V(8); PG8_WAIT_L(0); PG8_BAR; PG8_MMA(0, 0, At, B0); PG8_MMA(0, 1, At, B1); PG8_BAR; PG8_SCHED;
            PG8_LDA(At, 0, 1); PG8_STAGE(PG8_SB(0, 0), b2, voffB); PG8_STAGE(PG8_SB(0, 1), b2 + hstep, voffB); PG8_STAGE(PG8_SA(0, 0), a2, voffA);
            PG8_WAIT_V(8); PG8_WAIT_L(0); PG8_BAR; PG8_MMA(1, 0, At, B0); PG8_MMA(1, 1, At, B1); PG8_BAR; PG8_SCHED;
            PG8_LDB(B0, 1, 0); PG8_LDB(B1, 1, 1); PG8_SCHED; PG8_LDA(At, 1, 0); PG8_STAGE(PG8_SA(0, 1), a2 + hstep, voffA);
            PG8_WAIT_V(8); PG8_WAIT_L(0); PG8_BAR; PG8_MMA(0, 0, At, B0); PG8_MMA(0, 1, At, B1); PG8_BAR; PG8_SCHED;
            PG8_LDA(At, 1, 1); PG8_STAGE(PG8_SB(1, 0), b3, voffB); PG8_STAGE(PG8_SB(1, 1), b3 + hstep, voffB); PG8_STAGE(PG8_SA(1, 0), a3, voffA);
            PG8_WAIT_V(8); PG8_WAIT_L(0); PG8_BAR; PG8_MMA(1, 0, At, B0); PG8_MMA(1, 1, At, B1); PG8_BAR; PG8_SCHED;
            } else {
            PG8_LDB(B0, 0, 0); PG8_SCHED; PG8_LDA(At, 0, 0); PG8_STAGE(PG8_SA(1, 1), a1 + hstep, voffA);
            PG8_WAIT_L(8); PG8_BAR; PG8_WAIT_L(0); PG8_MMA(0, 0, At, B0); PG8_BAR; PG8_SCHED;
            PG8_LDB(B1, 0, 1); PG8_STAGE(PG8_SB(0, 0), b2, voffB);
            PG8_BAR; PG8_WAIT_L(0); PG8_MMA(0, 1, At, B1); PG8_BAR;
            PG8_LDA(At, 0, 1); PG8_STAGE(PG8_SA(0, 0), a2, voffA);
            PG8_BAR; PG8_WAIT_L(0); PG8_MMA(1, 0, At, B0); PG8_BAR; PG8_SCHED;
            PG8_STAGE(PG8_SB(0, 1), b2 + hstep, voffB);
            PG8_WAIT_V(6); PG8_BAR; PG8_MMA(1, 1, At, B1); PG8_BAR;
            PG8_LDB(B0, 1, 0); PG8_SCHED; PG8_LDA(At, 1, 0); PG8_STAGE(PG8_SA(0, 1), a2 + hstep, voffA);
            PG8_WAIT_L(8); PG8_BAR; PG8_WAIT_L(0); PG8_MMA(0, 0, At, B0); PG8_BAR; PG8_SCHED;
            PG8_LDB(B1, 1, 1); PG8_STAGE(PG8_SB(1, 0), b3, voffB);
            PG8_BAR; PG8_WAIT_L(0); PG8_MMA(0, 1, At, B1); PG8_BAR;
            PG8_LDA(At, 1, 1); PG8_STAGE(PG8_SA(1, 0), a3, voffA);
            PG8_BAR; PG8_WAIT_L(0); PG8_MMA(1, 0, At, B0); PG8_BAR; PG8_SCHED;
            PG8_STAGE(PG8_SB(1, 1), b3 + hstep, voffB);
            PG8_WAIT_V(6); PG8_BAR; PG8_MMA(1, 1, At, B1); PG8_BAR;
            }
        }
        if constexpr (ALIGN_EPI) { if (wr == 0) PG8_BAR; }
        if constexpr (!Epi::AFTER_DRAIN) { E(acc, cur, wr, wc, fr, fq); S.done(cur); }
        if (!has_next) break;
#pragma unroll
        for (int a = 0; a < 2; ++a)
#pragma unroll
            for (int b = 0; b < 2; ++b)
#pragma unroll
                for (int m = 0; m < 4; ++m)
#pragma unroll
                    for (int n = 0; n < 2; ++n) acc[a][b][m][n] = (f32x4){0.f, 0.f, 0.f, 0.f};
        cur = nxt; cA = nA; cB = nB; ++ui;
        if constexpr (ALIGN_EPI) { if (wr == 1) PG8_BAR; }
    }
    PG8_WAIT_V(0);
    if constexpr (!ALIGN_EPI) { if (wr == 0) PG8_BAR; }
    PG8_BAR;
    if constexpr (Epi::AFTER_DRAIN) { E.fused(acc, cur, wr, wc, fr, fq, lds, wid, lane); S.done(cur); }
#undef PG8_SA
#undef PG8_SB
#undef PG8_STAGE
#undef PG8_LDA
#undef PG8_LDB
#undef PG8_MMA
#undef PG8_WAIT_V
#undef PG8_WAIT_L
#undef PG8_BAR
#undef PG8_SCHED
}
}

constexpr int NWAVES = 8;
constexpr int NB = 8, SEQ = 2048, DM = 2048, M = NB * SEQ;
constexpr int DSGU = 768, DCONV = 768, DMEM = 512, DIN = 4352, DFF = 8192, NMEM = 256, HD = 128, CHUNK = 128;
constexpr int OFF_U = 0, OFF_V = 768, OFF_B = 1536, OFF_C = 2304, OFF_X = 3072, OFF_Q = 3840;
constexpr float EPS = 1e-6f;
constexpr float QSCALE = 0.08838834764831845f * 1.4426950408889634f;
#ifndef MK_N_LAUNCHES
#define MK_N_LAUNCHES 1
#endif
constexpr int N_PHASES = 7;
constexpr int N_LAUNCHES = MK_N_LAUNCHES;

constexpr size_t MiB = 1u << 20;
constexpr size_t WS_CTL = 0, CTL_ZERO_BYTES = 64 * 1024;
constexpr size_t WS_VSTATS = 1 * MiB;
constexpr size_t WS_SSQ1 = 3 * MiB;
constexpr size_t WS_SSQ2 = 5 * MiB;
constexpr size_t WS_WO = 8 * MiB;
constexpr size_t WS_W1 = 16 * MiB;
constexpr size_t WS_W2 = 48 * MiB;
constexpr size_t WS_KMAT = 80 * MiB;
constexpr size_t WS_VT = 82 * MiB;
constexpr size_t WS_BIG = 84 * MiB;
constexpr size_t WS_XN = WS_BIG, WS_MEMN = WS_BIG + 64 * MiB, WS_WIN = WS_BIG + 72 * MiB, WS_WKV = WS_BIG + 89 * MiB;
constexpr size_t WS_X1B = WS_XN;
constexpr size_t WS_PROJ = 180 * MiB;
constexpr size_t WS_HEADS = 316 * MiB;
constexpr size_t WS_HID = 180 * MiB;
constexpr size_t WS_END = 436 * MiB;
constexpr int CW_BAR = 1024;

constexpr int SCRATCH_BYTES = 139264;
constexpr int MISC_OFF = SCRATCH_BYTES;
constexpr int LDS_BYTES = 147456;

#define GAS __attribute__((address_space(1)))
#define LAS __attribute__((address_space(3)))
typedef unsigned short bf16;
typedef unsigned v4u __attribute__((ext_vector_type(4)));
typedef float f32x4 __attribute__((ext_vector_type(4)));
typedef short bf16x8 __attribute__((ext_vector_type(8)));
typedef GAS unsigned gu32;
typedef GAS unsigned long long gu64;
#define RLX_AGENT __ATOMIC_RELAXED, __HIP_MEMORY_SCOPE_AGENT
#define LDS_WAIT() asm volatile("s_waitcnt lgkmcnt(0)" ::: "memory")
#define VM_WAIT() asm volatile("s_waitcnt vmcnt(0)" ::: "memory")
__device__ __forceinline__ unsigned long long rt() { return __builtin_amdgcn_s_memrealtime(); }
__device__ __forceinline__ unsigned f2bf(float f) { unsigned u = __builtin_bit_cast(unsigned, f); return (u + 0x7fffu + ((u >> 16) & 1u)) >> 16; }
__device__ __forceinline__ unsigned pk2(float lo, float hi) { return f2bf(lo) | (f2bf(hi) << 16); }

#define XB_TMO      128
#define XB_XCNT(j)  (256  + 64 * (j))
#define XB_XSUB(j)  (1280 + 64 * (j))
#define XB_XGEN(j)  (2304 + 64 * (j))
#define XB_TOP      3328
#define XB_TOPGEN   3392
#define XCD_BAR_WORDS 3456
#define XB_SPIN_CAP (1u << 18)

__device__ __forceinline__ unsigned xb_ld(unsigned* p)              { return __hip_atomic_load(p, __ATOMIC_RELAXED, __HIP_MEMORY_SCOPE_AGENT); }
__device__ __forceinline__ unsigned xb_add(unsigned* p, unsigned v) { return __hip_atomic_fetch_add(p, v, __ATOMIC_RELAXED, __HIP_MEMORY_SCOPE_AGENT); }
__device__ __forceinline__ unsigned xb_xcc_id() { return (unsigned)__builtin_amdgcn_s_getreg((3 << 11) | 20) & 0xFu; }
#define XB_SPIN(cond, bar) do { unsigned _sp = 0; while (cond) { __builtin_amdgcn_s_sleep(1); \
    if ((++_sp & 255u) == 0u) { if (xb_ld(&(bar)[XB_TMO])) break; if (_sp > XB_SPIN_CAP) { atomicAdd(&(bar)[XB_TMO], 1u); break; } } } } while (0)

struct XcdBarrier {
    unsigned* bar; unsigned x;
    volatile LAS unsigned* st;
};

__device__ __forceinline__ XcdBarrier xcd_barrier_post(unsigned* bar, volatile LAS unsigned* st) {
    XcdBarrier b; b.bar = bar; b.x = xb_xcc_id(); b.st = st;
    if (threadIdx.x == 0) (void)xb_add(&bar[XB_XCNT(b.x)], 1u);
    return b;
}
__device__ __forceinline__ void xcd_barrier_complete(unsigned* bar, unsigned x, unsigned& nloc, unsigned& nx) {
    const unsigned G = gridDim.x * gridDim.y * gridDim.z;
    unsigned sum, cnt, mine, sp = 0u;
    for (;;) {
        sum = 0u; cnt = 0u; mine = 0u;
#pragma unroll
        for (unsigned j = 0; j < 16; ++j) { const unsigned c = xb_ld(&bar[XB_XCNT(j)]); sum += c; cnt += (c > 0u) ? 1u : 0u; mine = (j == x) ? c : mine; }
        if (sum == G) break;
        __builtin_amdgcn_s_sleep(1);
        if ((++sp & 255u) == 0u) { if (xb_ld(&bar[XB_TMO])) break; if (sp > XB_SPIN_CAP) { atomicAdd(&bar[XB_TMO], 1u); break; } }
    }
    nloc = mine > 0u ? mine : 1u; nx = cnt > 0u ? cnt : 1u;
}

__device__ __forceinline__ void xcd_barrier(const XcdBarrier& b) {
    asm volatile("s_waitcnt vmcnt(0)" ::: "memory");
    __syncthreads();
    if (threadIdx.x == 0) {
        unsigned* bar = b.bar;
        __builtin_amdgcn_s_waitcnt(0);
        unsigned nloc = b.st[0], nx = b.st[1];
        if (nloc == 0u) { xcd_barrier_complete(bar, b.x, nloc, nx); b.st[0] = nloc; b.st[1] = nx; }
        const unsigned old = xb_add(&bar[XB_XSUB(b.x)], 1u);
        const unsigned gen = old / nloc;
        if (old + 1u == (gen + 1u) * nloc) {
            __builtin_amdgcn_fence(__ATOMIC_RELEASE, "agent");
            asm volatile("s_waitcnt vmcnt(0)" ::: "memory");
            const unsigned og = xb_add(&bar[XB_TOP], 1u);
            const unsigned tg = og / nx;
            if (og + 1u == (tg + 1u) * nx) xb_add(&bar[XB_TOPGEN], 1u);
            else XB_SPIN(xb_ld(&bar[XB_TOPGEN]) == tg, bar);
            __builtin_amdgcn_fence(__ATOMIC_ACQUIRE, "agent");
            xb_add(&bar[XB_XGEN(b.x)], 1u);
            asm volatile("s_waitcnt vmcnt(0)" ::: "memory");
        } else {
            XB_SPIN(xb_ld(&bar[XB_XGEN(b.x)]) == gen, bar);
            __builtin_amdgcn_fence(__ATOMIC_ACQUIRE, "agent");
            asm volatile("s_waitcnt vmcnt(0)" ::: "memory");
        }
    }
    __syncthreads();
}

typedef unsigned v2u __attribute__((ext_vector_type(2)));
typedef float f32x2 __attribute__((ext_vector_type(2)));
typedef short bf16x4 __attribute__((ext_vector_type(4)));
__device__ __forceinline__ float bflo(unsigned u) { return __builtin_bit_cast(float, u << 16); }
__device__ __forceinline__ float bfhi(unsigned u) { return __builtin_bit_cast(float, u & 0xffff0000u); }
__device__ __forceinline__ void unpack8(const v4u w, float (&f)[8]) { f[0] = bflo(w.x); f[1] = bfhi(w.x); f[2] = bflo(w.y); f[3] = bfhi(w.y); f[4] = bflo(w.z); f[5] = bfhi(w.z); f[6] = bflo(w.w); f[7] = bfhi(w.w); }


struct Args {
    const float *x, *mem, *g_mix, *w_in, *ln_g, *ln_b, *w_s, *b_s, *conv_w, *g_mem, *w_kv, *g_head, *w_o, *g_ffn, *w1, *w2, *g_final;
    float* out; unsigned char* ws; int ph_lo, ph_hi;
};

__device__ __forceinline__ float wave_sum(float v) {
#pragma unroll
    for (int o = 1; o < 64; o <<= 1) v += __shfl_xor(v, o);
    return v;
}
__device__ __forceinline__ void p0_transpose_item(const float* W, int K, int N, bf16* WT, const float* ks, LAS float* scr, int item, int lane) {
    const int nblk = N / 32, kb = item / nblk, nb = item % nblk, k0 = 64 * kb, n0 = 32 * nb;
#pragma unroll 8
    for (int i = 0; i < 32; ++i) { const int kk = 2 * i + (lane >> 5); float w = W[(size_t)(k0 + kk) * N + n0 + (lane & 31)]; if (ks) w *= ks[k0 + kk]; scr[kk * 33 + (lane & 31)] = w; }
    LDS_WAIT(); asm volatile("" ::: "memory");
    const int c = lane & 7;
#pragma unroll
    for (int j = 0; j < 4; ++j) { const int n = (lane >> 3) + 8 * j; const LAS float* s = scr + (8 * c) * 33 + n;
        v4u o; o.x = pk2(s[0 * 33], s[1 * 33]); o.y = pk2(s[2 * 33], s[3 * 33]); o.z = pk2(s[4 * 33], s[5 * 33]); o.w = pk2(s[6 * 33], s[7 * 33]);
        *(GAS v4u*)(WT + (size_t)(n0 + n) * K + k0 + 8 * c) = o; }
    LDS_WAIT(); asm volatile("" ::: "memory");
}
__device__ __forceinline__ void rms_row_to_bf16(const float* xrow, const float* gain, bf16* orow, int lane) {
    const GAS f32x4* xr = (const GAS f32x4*)xrow + lane; const GAS f32x4* gr = (const GAS f32x4*)gain + lane;
    f32x4 v[8]; float s = 0.f;
#pragma unroll
    for (int j = 0; j < 8; ++j) { v[j] = xr[64 * j]; s += (v[j].x * v[j].x + v[j].y * v[j].y) + (v[j].z * v[j].z + v[j].w * v[j].w); }
    const float rinv = 1.0f / sqrtf(wave_sum(s) * (1.f / DM) + EPS);
    GAS v2u* o8 = (GAS v2u*)orow + lane;
#pragma unroll
    for (int j = 0; j < 8; ++j) { const f32x4 g = gr[64 * j]; v2u o; o.x = pk2(v[j].x * rinv * g.x, v[j].y * rinv * g.y); o.y = pk2(v[j].z * rinv * g.z, v[j].w * rinv * g.w); o8[64 * j] = o; }
}

__device__ __forceinline__ void head_norm_store(float (&v)[4][8], size_t row, int hcol0, int g, const float* g_head, bf16* heads) {
    float s = 0.f;
#pragma unroll
    for (int p = 0; p < 4; ++p)
#pragma unroll
        for (int e = 0; e < 8; ++e) s += v[p][e] * v[p][e];
    s += __shfl_xor(s, 16); s += __shfl_xor(s, 32);
    const float rinv = 1.0f / sqrtf(s * (1.f / HD) + EPS);
#pragma unroll
    for (int p = 0; p < 4; ++p) {
        const int c = hcol0 + 32 * p + 8 * g;
        const f32x4 g0 = *(const GAS f32x4*)(g_head + c), g1 = *(const GAS f32x4*)(g_head + c + 4);
        v4u w; w.x = pk2(v[p][0] * rinv * g0.x, v[p][1] * rinv * g0.y); w.y = pk2(v[p][2] * rinv * g0.z, v[p][3] * rinv * g0.w);
        w.z = pk2(v[p][4] * rinv * g1.x, v[p][5] * rinv * g1.y); w.w = pk2(v[p][6] * rinv * g1.z, v[p][7] * rinv * g1.w);
        *(GAS v4u*)(heads + row * DM + c) = w;
    }
}

constexpr int VROW = 272;
constexpr int KROW = 272;
constexpr int VTROW = 528;
constexpr int K_BYTES = 256 * KROW;
static_assert(K_BYTES + 128 * VTROW <= SCRATCH_BYTES, "attention tiles fit the scratch");

__device__ __forceinline__ void sgu_unit(const Args& A, LAS unsigned char* lds, int R0, int h, int tid) {
    const bf16* proj = (const bf16*)(A.ws + WS_PROJ); const float* vstats = (const float*)(A.ws + WS_VSTATS); bf16* heads = (bf16*)(A.ws + WS_HEADS);
    const int lane = tid & 63, w = __builtin_amdgcn_readfirstlane(tid >> 6), fr = lane & 15, g = lane >> 4;
    {
        const int sp = tid >> 3, dc = tid & 7, d0 = 16 * dc;
        float mean[2], rstd[2];
#pragma unroll
        for (int r = 0; r < 2; ++r) {
            const GAS f32x4* st = (const GAS f32x4*)(vstats + (size_t)(R0 + 2 * sp + r) * 24);
            float s1 = 0.f, s2 = 0.f;
#pragma unroll
            for (int i = 0; i < 6; ++i) { const f32x4 t = st[i]; s1 += t.x + t.z; s2 += t.y + t.w; }
            mean[r] = s1 * (1.f / DSGU); const float var = s2 * (1.f / DSGU) - mean[r] * mean[r]; rstd[r] = 1.0f / sqrtf(fmaxf(var, 0.f) + EPS);
        }
        float val[2][16];
#pragma unroll
        for (int r = 0; r < 2; ++r) {
            const GAS v4u* src = (const GAS v4u*)(proj + (size_t)(R0 + 2 * sp + r) * DIN + OFF_V + h * HD + d0);
            float f0[8], f1[8]; unpack8(src[0], f0); unpack8(src[1], f1);
#pragma unroll
            for (int e = 0; e < 8; ++e) { val[r][e] = (f0[e] - mean[r]) * rstd[r]; val[r][8 + e] = (f1[e] - mean[r]) * rstd[r]; }
        }
#pragma unroll
        for (int q = 0; q < 4; ++q) {
            const f32x4 lg = *(const GAS f32x4*)(A.ln_g + h * HD + d0 + 4 * q), lb = *(const GAS f32x4*)(A.ln_b + h * HD + d0 + 4 * q);
#pragma unroll
            for (int e = 0; e < 4; ++e) {
                const int i = 4 * q + e;
                const float a = val[0][i] * lg[e] + lb[e], b = val[1][i] * lg[e] + lb[e];
                *(LAS unsigned*)(lds + (d0 + i) * VROW + 4 * sp) = pk2(a, b);
            }
        }
    }
    __syncthreads();
    f32x4 acc[4][2];
#pragma unroll
    for (int p = 0; p < 4; ++p)
#pragma unroll
        for (int q = 0; q < 2; ++q) acc[p][q] = (f32x4){0.f, 0.f, 0.f, 0.f};
    const int t = 16 * w + fr;
    const int nks = (w >> 1) + 1;
    const float* wrow = A.w_s + ((size_t)h * CHUNK + t) * CHUNK;
    for (int ks = 0; ks < nks; ++ks) {
        const int s0 = 32 * ks + 8 * g;
        const f32x4 w0 = *(const GAS f32x4*)(wrow + s0), w1 = *(const GAS f32x4*)(wrow + s0 + 4);
        float wf[8] = {w0.x, w0.y, w0.z, w0.w, w1.x, w1.y, w1.z, w1.w};
#pragma unroll
        for (int e = 0; e < 8; ++e) wf[e] = (s0 + e <= t) ? wf[e] : 0.f;
        v4u bw; bw.x = pk2(wf[0], wf[1]); bw.y = pk2(wf[2], wf[3]); bw.z = pk2(wf[4], wf[5]); bw.w = pk2(wf[6], wf[7]);
        const bf16x8 bfrag = __builtin_bit_cast(bf16x8, bw);
#pragma unroll
        for (int p = 0; p < 4; ++p)
#pragma unroll
            for (int q = 0; q < 2; ++q) {
                const int drow = 32 * p + 8 * (fr >> 2) + 4 * q + (fr & 3);
                const bf16x8 afrag = *(const LAS bf16x8*)(lds + drow * VROW + 64 * ks + 16 * g);
                acc[p][q] = __builtin_amdgcn_mfma_f32_16x16x32_bf16(afrag, bfrag, acc[p][q], 0, 0, 0);
            }
    }
    const float bias = A.b_s[h * CHUNK + t];
    float v[4][8];
#pragma unroll
    for (int p = 0; p < 4; ++p) {
        float gu[8]; unpack8(*(const GAS v4u*)(proj + (size_t)(R0 + t) * DIN + OFF_U + h * HD + 32 * p + 8 * g), gu);
#pragma unroll
        for (int q = 0; q < 2; ++q)
#pragma unroll
            for (int e = 0; e < 4; ++e) v[p][4 * q + e] = gu[4 * q + e] * (acc[p][q][e] + bias);
    }
    head_norm_store(v, (size_t)(R0 + t), h * HD, g, A.g_head, heads);
    __syncthreads();
}

__device__ __forceinline__ void conv_unit(const Args& A, int R0, int tpos0, int grp, int tid) {
    const bf16* proj = (const bf16*)(A.ws + WS_PROJ); bf16* heads = (bf16*)(A.ws + WS_HEADS);
    const int lane = tid & 63, w = tid >> 6, fr = lane & 15, g = lane >> 4;
    const int t = 16 * w + fr; const size_t row = (size_t)(R0 + t); const int tpos = tpos0 + t;
    float v[4][8];
#pragma unroll
    for (int p = 0; p < 4; ++p) {
        const int col = grp * HD + 32 * p + 8 * g;
        float y[8];
#pragma unroll
        for (int e = 0; e < 8; ++e) y[e] = 0.f;
#pragma unroll
        for (int k = 0; k < 3; ++k) {
            const int back = 2 - k;
            if (tpos - back >= 0) {
                float c[8], xin[8];
                unpack8(*(const GAS v4u*)(proj + (row - back) * DIN + OFF_C + col), c);
                unpack8(*(const GAS v4u*)(proj + (row - back) * DIN + OFF_X + col), xin);
                const f32x4 k0 = *(const GAS f32x4*)(A.conv_w + k * DCONV + col), k1 = *(const GAS f32x4*)(A.conv_w + k * DCONV + col + 4);
                const float kw[8] = {k0.x, k0.y, k0.z, k0.w, k1.x, k1.y, k1.z, k1.w};
#pragma unroll
                for (int e = 0; e < 8; ++e) y[e] += kw[e] * (c[e] * xin[e]);
            }
        }
        float bg[8]; unpack8(*(const GAS v4u*)(proj + row * DIN + OFF_B + col), bg);
#pragma unroll
        for (int e = 0; e < 8; ++e) v[p][e] = bg[e] * y[e];
    }
    head_norm_store(v, row, DSGU + grp * HD, g, A.g_head, heads);
}

__device__ __forceinline__ void attn_stage(const Args& A, LAS unsigned char* lds, int b, int h, int tid) {
    const bf16* kmat = (const bf16*)(A.ws + WS_KMAT); const bf16* vt = (const bf16*)(A.ws + WS_VT);
#pragma unroll
    for (int it = 0; it < 8; ++it) {
        const int idx = tid + 512 * it;
        { const int key = idx >> 4, ch = idx & 15; const v4u d = *(const GAS v4u*)(kmat + (size_t)(b * NMEM + key) * DMEM + h * HD + 8 * ch); *(LAS v4u*)(lds + key * KROW + 16 * ch) = d; }
        { const int dd = idx >> 5, ch = idx & 31; const v4u d = *(const GAS v4u*)(vt + (size_t)(h * HD + dd) * (NB * NMEM) + b * NMEM + 8 * ch); *(LAS v4u*)(lds + K_BYTES + dd * VTROW + 16 * ch) = d; }
    }
}
__device__ __forceinline__ void attn_chunk(const Args& A, LAS unsigned char* lds, int R0, int h, int tid) {
    const bf16* proj = (const bf16*)(A.ws + WS_PROJ); bf16* heads = (bf16*)(A.ws + WS_HEADS);
    const int lane = tid & 63, w = tid >> 6, fr = lane & 15, g = lane >> 4;
    const size_t row = (size_t)(R0 + 16 * w + fr);
    bf16x8 qf[4];
#pragma unroll
    for (int ks = 0; ks < 4; ++ks) qf[ks] = __builtin_bit_cast(bf16x8, *(const GAS v4u*)(proj + row * DIN + OFF_Q + h * HD + 32 * ks + 8 * g));
    f32x4 sacc[16];
    bf16x8 kf[2][4];
#pragma unroll
    for (int ks = 0; ks < 4; ++ks) kf[0][ks] = *(const LAS bf16x8*)(lds + fr * KROW + 64 * ks + 16 * g);
#pragma unroll
    for (int kt = 0; kt < 16; ++kt) {
        if (kt + 1 < 16) {
#pragma unroll
            for (int ks = 0; ks < 4; ++ks) kf[(kt + 1) & 1][ks] = *(const LAS bf16x8*)(lds + (16 * (kt + 1) + fr) * KROW + 64 * ks + 16 * g);
        }
        sacc[kt] = (f32x4){0.f, 0.f, 0.f, 0.f};
#pragma unroll
        for (int ks = 0; ks < 4; ++ks) sacc[kt] = __builtin_amdgcn_mfma_f32_16x16x32_bf16(kf[kt & 1][ks], qf[ks], sacc[kt], 0, 0, 0);
        asm volatile("" ::: "memory");
    }
    float mx = -3.0e38f;
#pragma unroll
    for (int kt = 0; kt < 16; ++kt) mx = fmaxf(mx, fmaxf(fmaxf(sacc[kt][0], sacc[kt][1]), fmaxf(sacc[kt][2], sacc[kt][3])));
    mx = fmaxf(mx, __shfl_xor(mx, 16)); mx = fmaxf(mx, __shfl_xor(mx, 32));
    float l = 0.f;
#pragma unroll
    for (int kt = 0; kt < 16; ++kt)
#pragma unroll
        for (int e = 0; e < 4; ++e) { const float p = __builtin_amdgcn_exp2f(sacc[kt][e] - mx); sacc[kt][e] = p; l += p; }
    l += __shfl_xor(l, 16); l += __shfl_xor(l, 32);
    f32x4 oacc[4][2];
#pragma unroll
    for (int p = 0; p < 4; ++p)
#pragma unroll
        for (int q = 0; q < 2; ++q) oacc[p][q] = (f32x4){0.f, 0.f, 0.f, 0.f};
    v4u af[2][4][2];
    const LAS unsigned char* vbase = lds + K_BYTES + (8 * (fr >> 2) + (fr & 3)) * VTROW + 8 * g;
#define LOAD_AF(buf, s_) do { _Pragma("unroll") for (int p = 0; p < 4; ++p) _Pragma("unroll") for (int q = 0; q < 2; ++q) { \
        const LAS unsigned char* a0 = vbase + (32 * p + 4 * q) * VTROW + 64 * (s_); const v2u lo_ = *(const LAS v2u*)a0, hi_ = *(const LAS v2u*)(a0 + 32); \
        af[buf][p][q] = (v4u){lo_.x, lo_.y, hi_.x, hi_.y}; } } while (0)
    LOAD_AF(0, 0);
#pragma unroll
    for (int s = 0; s < 8; ++s) {
        if (s + 1 < 8) LOAD_AF((s + 1) & 1, s + 1);
        v4u pw; pw.x = pk2(sacc[2 * s][0], sacc[2 * s][1]); pw.y = pk2(sacc[2 * s][2], sacc[2 * s][3]); pw.z = pk2(sacc[2 * s + 1][0], sacc[2 * s + 1][1]); pw.w = pk2(sacc[2 * s + 1][2], sacc[2 * s + 1][3]);
        const bf16x8 pf = __builtin_bit_cast(bf16x8, pw);
#pragma unroll
        for (int p = 0; p < 4; ++p)
#pragma unroll
            for (int q = 0; q < 2; ++q)
                oacc[p][q] = __builtin_amdgcn_mfma_f32_16x16x32_bf16(__builtin_bit_cast(bf16x8, af[s & 1][p][q]), pf, oacc[p][q], 0, 0, 0);
        asm volatile("" ::: "memory");
    }
#undef LOAD_AF
    const float linv = 1.0f / l;
    float v[4][8];
#pragma unroll
    for (int p = 0; p < 4; ++p)
#pragma unroll
        for (int q = 0; q < 2; ++q)
#pragma unroll
            for (int e = 0; e < 4; ++e) v[p][4 * q + e] = oacc[p][q][e] * linv;
    head_norm_store(v, row, DSGU + DCONV + h * HD, g, A.g_head, heads);
}

__global__ void __launch_bounds__(NWAVES * 64, 2) fwd_kernel(Args args) {
    extern __shared__ __attribute__((aligned(16))) unsigned char lds_raw[];
    LAS unsigned char* lds = (LAS unsigned char*)lds_raw;
    volatile LAS unsigned* MISC = (volatile LAS unsigned*)(lds + MISC_OFF);
    const int tid = threadIdx.x, lane = tid & 63, wave = __builtin_amdgcn_readfirstlane(tid >> 6);
    const int G = gridDim.x, bx = blockIdx.x;
    const int vcu = (G % 8 == 0) ? (bx % 8) * (G / 8) + bx / 8 : bx;
    unsigned char* ws = args.ws;
    for (int u = tid; u < (LDS_BYTES - MISC_OFF) / 4; u += NWAVES * 64) ((LAS unsigned*)(lds + MISC_OFF))[u] = 0u;
    __syncthreads();
    XcdBarrier bar; bar.bar = (unsigned*)(ws + WS_CTL) + CW_BAR; bar.x = 0; bar.st = nullptr;
    if (N_LAUNCHES == 1) bar = xcd_barrier_post((unsigned*)(ws + WS_CTL) + CW_BAR, MISC + 8);
    const int lo = args.ph_lo, hi = args.ph_hi;
#define IN(k) (lo <= (k) && (k) < hi)
#define SEAM(k) do { if (IN(k) && IN((k) + 1)) xcd_barrier(bar); } while (0)
    bf16* BIG = (bf16*)(ws + WS_BIG);

    if (IN(0)) {
        LAS float* scr = (LAS float*)(lds + wave * 16384);
        const int gw = vcu * NWAVES + wave, NGW = G * NWAVES;
        constexpr int I_IN = (DM / 64) * (DIN / 32), I_KV = (DM / 64) * (2 * DMEM / 32), I_O = (DM / 64) * (DM / 32), I_1 = (DM / 64) * (DFF / 32), I_2 = (DFF / 64) * (DM / 32);
        constexpr int NITEMS = I_IN + I_KV + I_O + I_1 + I_2;
        for (int it = gw; it < NITEMS; it += NGW) {
            int r = it;
            if (r < I_IN) { p0_transpose_item(args.w_in, DM, DIN, (bf16*)(ws + WS_WIN), nullptr, scr, r, lane); continue; } r -= I_IN;
            if (r < I_KV) { p0_transpose_item(args.w_kv, DM, 2 * DMEM, (bf16*)(ws + WS_WKV), nullptr, scr, r, lane); continue; } r -= I_KV;
            if (r < I_O) { p0_transpose_item(args.w_o, DM, DM, (bf16*)(ws + WS_WO), nullptr, scr, r, lane); continue; } r -= I_O;
            if (r < I_1) { p0_transpose_item(args.w1, DM, DFF, (bf16*)(ws + WS_W1), args.g_ffn, scr, r, lane); continue; } r -= I_1;
            p0_transpose_item(args.w2, DFF, DM, (bf16*)(ws + WS_W2), nullptr, scr, r, lane);
        }
        for (int m = gw; m < M + NB * NMEM; m += NGW) {
            if (m < M) rms_row_to_bf16(args.x + (size_t)m * DM, args.g_mix, (bf16*)(ws + WS_XN) + (size_t)m * DM, lane);
            else rms_row_to_bf16(args.mem + (size_t)(m - M) * DM, args.g_mem, (bf16*)(ws + WS_MEMN) + (size_t)(m - M) * DM, lane);
        }
    }
    SEAM(0);
    if (IN(1)) {
        pg8::Gemm g{BIG, BIG, 0, 0, DM}; pg8::Order1 S; S.init(G, bx);
        pg8::Epi1 E{(bf16*)(ws + WS_PROJ), (bf16*)(ws + WS_KMAT), (bf16*)(ws + WS_VT), (float*)(ws + WS_VSTATS), QSCALE};
        pg8::gemm_phase<pg8::Epi1, pg8::Order1, true, true>(lds, g, S, E);
    }
    SEAM(1);
    if (IN(2)) {
        for (int s = bx; s < 768; s += G) { const int h = s % 6, bc = s / 6; sgu_unit(args, lds, bc * CHUNK, h, tid); }
        for (int s = bx; s < 768; s += G) { const int grp = s % 6, bc = s / 6; conv_unit(args, bc * CHUNK, (bc & 15) * CHUNK, grp, tid); }
        for (int a = vcu; a < 256; a += G) {
            const int bh = a >> 3, cp = a & 7, b = bh >> 2, h = bh & 3;
            attn_stage(args, lds, b, h, tid);
            __syncthreads();
#pragma unroll 1
            for (int r = 0; r < 2; ++r) attn_chunk(args, lds, b * SEQ + (cp + 8 * r) * CHUNK, h, tid);
            __syncthreads();
        }
    }
    SEAM(2);
    if (IN(3)) {
        pg8::Gemm g{(const bf16*)(ws + WS_HEADS), (const bf16*)(ws + WS_WO), M, DM, DM}; pg8::StaticOrder S; S.init(M, DM, G, bx);
        pg8::Epi3 E{args.x, (bf16*)(ws + WS_X1B), (float*)(ws + WS_SSQ1)};
        pg8::gemm_phase<pg8::Epi3, pg8::StaticOrder, true, true>(lds, g, S, E);
    }
    SEAM(3);
    if (IN(4)) {
        pg8::Gemm g{(const bf16*)(ws + WS_X1B), (const bf16*)(ws + WS_W1), M, DFF, DM}; pg8::StaticOrder S; S.init(M, DFF, G, bx);
        pg8::Epi4 E{(bf16*)(ws + WS_HID), (const float*)(ws + WS_SSQ1)};
        pg8::gemm_phase<pg8::Epi4, pg8::StaticOrder, true, true>(lds, g, S, E);
    }
    SEAM(4);
    if (IN(5)) {
        pg8::Gemm g{(const bf16*)(ws + WS_HID), (const bf16*)(ws + WS_W2), M, DM, DFF}; pg8::StaticOrder S; S.init(M, DM, G, bx);
        pg8::Epi5 E{(bf16*)(ws + WS_X1B), (float*)(ws + WS_SSQ2)};
        pg8::gemm_phase<pg8::Epi5, pg8::StaticOrder, true, true>(lds, g, S, E);
    }
    SEAM(5);
    if (IN(6)) {
        const int gw = bx * NWAVES + wave, NGW = G * NWAVES;
        const float* ssq2 = (const float*)(ws + WS_SSQ2);
        for (int m = gw; m < M; m += NGW) {
            const float part = lane < 32 ? ssq2[(size_t)m * 32 + lane] : 0.f;
            const float rinv = 1.0f / sqrtf(wave_sum(part) * (1.f / DM) + EPS);
            const GAS v4u* xr = (const GAS v4u*)((const bf16*)(ws + WS_X1B) + (size_t)m * DM) + lane;
            GAS f32x4* ow = (GAS f32x4*)(args.out + (size_t)m * DM) + 2 * lane; const GAS f32x4* gr = (const GAS f32x4*)args.g_final + 2 * lane;
            v4u v[4];
#pragma unroll
            for (int j = 0; j < 4; ++j) v[j] = xr[64 * j];
#pragma unroll
            for (int j = 0; j < 4; ++j) {
                float f[8]; unpack8(v[j], f); const f32x4 g0 = gr[128 * j], g1 = gr[128 * j + 1];
                ow[128 * j] = (f32x4){f[0] * rinv * g0.x, f[1] * rinv * g0.y, f[2] * rinv * g0.z, f[3] * rinv * g0.w};
                ow[128 * j + 1] = (f32x4){f[4] * rinv * g1.x, f[5] * rinv * g1.y, f[6] * rinv * g1.z, f[7] * rinv * g1.w};
            }
        }
    }
#undef IN
#undef SEAM
}

extern "C" void kernel_launch(void* const* d_in, const int* in_sizes, int n_in, void* d_out, int out_size, void* d_ws, size_t ws_size, hipStream_t stream) {
    static int grid = 0;
    if (grid == 0) {
        if (n_in != 17 || in_sizes[0] != M * DM || out_size != M * DM || ws_size < WS_END) { fprintf(stderr, "kernel_launch: unexpected shapes (n_in %d, in0 %d, out %d, ws %zu); nothing launched\n", n_in, n_in > 0 ? in_sizes[0] : -1, out_size, ws_size); grid = -1; return; }
        int dev = 0, cus = 0, per_cu = 0;
        if (hipGetDevice(&dev) != hipSuccess || hipDeviceGetAttribute(&cus, hipDeviceAttributeMultiprocessorCount, dev) != hipSuccess) { grid = -1; return; }
        if (hipFuncSetAttribute((const void*)fwd_kernel, hipFuncAttributeMaxDynamicSharedMemorySize, LDS_BYTES) != hipSuccess) { fprintf(stderr, "kernel_launch: hipFuncSetAttribute failed\n"); grid = -1; return; }
        if (hipOccupancyMaxActiveBlocksPerMultiprocessor(&per_cu, (const void*)fwd_kernel, NWAVES * 64, LDS_BYTES) != hipSuccess || per_cu < 1) { fprintf(stderr, "kernel_launch: occupancy query says %d blocks per CU\n", per_cu); (void)hipGetLastError(); grid = -1; return; }
        grid = cus;
    }
    if (grid < 0) return;
    (void)hipMemsetAsync((char*)d_ws + WS_CTL, 0, CTL_ZERO_BYTES, stream);
    Args a{};
    const float** p = (const float**)&a;
    for (int i = 0; i < 17; ++i) p[i] = (const float*)d_in[i];
    a.out = (float*)d_out; a.ws = (unsigned char*)d_ws;
    for (int li = 0; li < N_LAUNCHES; ++li) {
        a.ph_lo = (N_LAUNCHES == 1) ? 0 : li; a.ph_hi = (N_LAUNCHES == 1) ? N_PHASES : li + 1;
        hipLaunchKernelGGL(fwd_kernel, dim3(grid), dim3(NWAVES * 64), LDS_BYTES, stream, a);
        const hipError_t le = hipPeekAtLastError();
        if (le != hipSuccess) { fprintf(stderr, "kernel_launch: launch %d failed: %s\n", li, hipGetErrorName(le)); break; }
    }
}
```

```cpp
#include <hip/hip_runtime.h>
#include <cstdio>
#include <cstdint>
namespace pg8 {
#define PG8_LAS __attribute__((address_space(3)))
typedef unsigned short bf16_t;
typedef short bf16x8 __attribute__((ext_vector_type(8)));
typedef float f32x4 __attribute__((ext_vector_type(4)));
typedef unsigned u32x4 __attribute__((ext_vector_type(4)));
constexpr int BM = 256, BK = 64, HALF = 128, HTB = HALF * BK * 2  , STAGE_BYTES = 8 * HTB, NXCD = 8, WGM = 8;

__host__ __device__ __forceinline__ int lds_byte(int r, int c) { const int st = (r >> 4) * 2 + (c >> 5), rr = r & 15, cc = c & 31, ob = rr * 64 + cc * 2; return st * 1024 + (ob ^ (((ob >> 9) & 1) << 5)); }
__host__ __device__ __forceinline__ void stage_rc(int b, int& R, int& C) { const int st = b / 1024, sb = b % 1024, swz = sb ^ (((sb >> 9) & 1) << 5); R = (st >> 1) * 16 + swz / 64; C = (st & 1) * 32 + (swz % 64) / 2; }
__host__ __device__ __forceinline__ int perm32(int rho) { const int n = rho >> 4, i = rho & 15; return 8 * (i >> 2) + 4 * n + (i & 3); }

struct Unit { int pm, pn; };
struct Gemm { const bf16_t* A; const bf16_t* Bt; int M, N, K; };

struct StaticOrder {
    int nM, nN, nwg, G, c;
    __host__ __device__ void init(int M, int N, int G_, int c_) { nM = M / BM; nN = N / BM; nwg = nM * nN; G = G_; c = c_; }
    __host__ __device__ bool next(int i, Unit& u) const {
        const long L = (long)i * G + c; if (L >= nwg) return false;
        int wgid = (int)L; { const int q = nwg / NXCD, r = nwg % NXCD, xcd = wgid % NXCD, off = wgid / NXCD; wgid = (xcd < r ? xcd * (q + 1) : r * (q + 1) + (xcd - r) * q) + off; }
        const int nig = WGM * nN, gid = wgid / nig, fm = gid * WGM, gsz = (nM - fm) < WGM ? (nM - fm) : WGM;
        u.pm = fm + ((wgid % nig) % gsz); u.pn = (wgid % nig) / gsz; return true;
    }
    __device__ __forceinline__ void a_ready(const Unit&) const {}
    __device__ __forceinline__ void done(const Unit&) const {}
};

__device__ __forceinline__ unsigned cvt_pk_bf16(float lo, float hi) { unsigned r; asm volatile("v_cvt_pk_bf16_f32 %0, %1, %2" : "=v"(r) : "v"(lo), "v"(hi)); return r; }
typedef float f32x2 __attribute__((ext_vector_type(2)));
typedef unsigned u32x2 __attribute__((ext_vector_type(2)));
__device__ __forceinline__ float gelu_t(float x) {
    const float t = x * (2.302208198f + 0.1029432397f * x * x);
    return x * __builtin_amdgcn_rcpf(1.0f + __builtin_amdgcn_exp2f(-t));
}
constexpr int E_DIN = 4352, E_DM = 2048, E_DFF = 8192;
constexpr float E_EPS = 1e-6f;
constexpr int PAN_MEMN = 64, PAN_WIN = 72, PAN_WKV = 89;

struct Order1 {
    StaticOrder so; int G, c;
    __device__ void init(int G_, int c_) { so.init(16384, E_DIN, G_, c_); G = G_; c = c_; }
    __device__ bool next(int i, Unit& u) const {
        const int L = i * G + c;
        if (L < 1088) { Unit t; so.next(i, t); u.pm = t.pm; u.pn = PAN_WIN + t.pn; return true; }
        const int r = L - 1088;
        if (r < 16) { u.pm = PAN_MEMN + (r & 7); u.pn = PAN_WKV + (r >> 3); return true; }
        if (r < 32) { const int q = r - 16; u.pm = PAN_WKV + 2 + (q >> 3); u.pn = PAN_MEMN + (q & 7); return true; }
        return false;
    }
    __device__ __forceinline__ void a_ready(const Unit&) const {}
    __device__ __forceinline__ void done(const Unit&) const {}
};

struct Epi1 {
    static constexpr bool PERM = true, AFTER_DRAIN = false;
    bf16_t* proj; bf16_t* kmat; bf16_t* vt; float* vstats; float qscale;
    __device__ __forceinline__ void operator()(const f32x4 (&acc)[2][2][4][2], const Unit& u, int wr, int wc, int fr, int fq) const {
        bf16_t* base; int ld, mode, rowt, colt, j = 0;
        const int pa = u.pm, pb = u.pn;
        if (pb >= PAN_WIN && pb < PAN_WKV) { j = pb - PAN_WIN; base = proj; ld = E_DIN; rowt = pa * 256; colt = j * 256; mode = j < 3 ? 1 : (j < 6 ? 2 : (j >= 15 ? 3 : 0)); }
        else if (pb >= PAN_WKV) { base = kmat; ld = 512; rowt = (pa - PAN_MEMN) * 256; colt = (pb - PAN_WKV) * 256; mode = 0; }
        else { base = vt; ld = 2048; rowt = (pa - PAN_WKV - 2) * 256; colt = (pb - PAN_MEMN) * 256; mode = 0; }
        const int row0 = rowt + wr * 64 + fr, col0 = colt + wc * 32 + 8 * fq;
        const float sc = mode == 3 ? qscale : 1.0f;
#pragma unroll
        for (int ai = 0; ai < 2; ++ai)
#pragma unroll
            for (int m = 0; m < 4; ++m) {
                const int row = row0 + ai * HALF + m * 16;
                bf16_t* rowp = base + (size_t)row * ld + col0;
                float s1 = 0.f, s2 = 0.f;
#pragma unroll
                for (int bj = 0; bj < 2; ++bj) {
                    f32x4 v0 = acc[ai][bj][m][0], v1 = acc[ai][bj][m][1];
                    if (mode == 1 || mode == 2) {
#pragma unroll
                        for (int e = 0; e < 4; ++e) { v0[e] = gelu_t(v0[e]); v1[e] = gelu_t(v1[e]); }
                        if (mode == 2) {
#pragma unroll
                            for (int e = 0; e < 4; ++e) { s1 += v0[e] + v1[e]; s2 += v0[e] * v0[e] + v1[e] * v1[e]; }
                        }
                    } else { v0 = v0 * sc; v1 = v1 * sc; }
                    u32x4 w; w.x = cvt_pk_bf16(v0[0], v0[1]); w.y = cvt_pk_bf16(v0[2], v0[3]); w.z = cvt_pk_bf16(v1[0], v1[1]); w.w = cvt_pk_bf16(v1[2], v1[3]);
                    *(u32x4*)(rowp + bj * HALF) = w;
                }
                if (mode == 2) {
                    s1 += __shfl_xor(s1, 16); s1 += __shfl_xor(s1, 32); s2 += __shfl_xor(s2, 16); s2 += __shfl_xor(s2, 32);
                    if (fq == 0) *(f32x2*)(vstats + ((size_t)row * 12 + (j - 3) * 4 + wc) * 2) = (f32x2){s1, s2};
                }
            }
    }
};
struct Epi3 {
    static constexpr bool PERM = true, AFTER_DRAIN = false;
    const float* x; bf16_t* x1b; float* ssq;
    __device__ __forceinline__ void operator()(const f32x4 (&acc)[2][2][4][2], const Unit& u, int wr, int wc, int fr, int fq) const {
        const int row0 = u.pm * BM + wr * 64 + fr, col0 = u.pn * BM + wc * 32 + 8 * fq;
#pragma unroll
        for (int ai = 0; ai < 2; ++ai)
#pragma unroll
            for (int m = 0; m < 4; ++m) {
                const int row = row0 + ai * HALF + m * 16; const size_t off = (size_t)row * E_DM + col0; float s = 0.f;
#pragma unroll
                for (int bj = 0; bj < 2; ++bj) {
                    const f32x4 o0 = *(const f32x4*)(x + off + bj * HALF) + acc[ai][bj][m][0], o1 = *(const f32x4*)(x + off + bj * HALF + 4) + acc[ai][bj][m][1];
                    s += ((o0[0] * o0[0] + o0[1] * o0[1]) + (o0[2] * o0[2] + o0[3] * o0[3])) + ((o1[0] * o1[0] + o1[1] * o1[1]) + (o1[2] * o1[2] + o1[3] * o1[3]));
                    u32x4 w; w.x = cvt_pk_bf16(o0[0], o0[1]); w.y = cvt_pk_bf16(o0[2], o0[3]); w.z = cvt_pk_bf16(o1[0], o1[1]); w.w = cvt_pk_bf16(o1[2], o1[3]);
                    *(u32x4*)(x1b + off + bj * HALF) = w;
                }
                s += __shfl_xor(s, 16); s += __shfl_xor(s, 32);
                if (fq == 0) ssq[(size_t)row * 32 + u.pn * 4 + wc] = s;
            }
    }
};
struct Epi4 {
    static constexpr bool PERM = true, AFTER_DRAIN = false;
    bf16_t* hid; const float* ssq;
    __device__ __forceinline__ void operator()(const f32x4 (&acc)[2][2][4][2], const Unit& u, int wr, int wc, int fr, int fq) const {
        const int row0 = u.pm * BM + wr * 64 + fr, col0 = u.pn * BM + wc * 32 + 8 * fq;
#pragma unroll
        for (int ai = 0; ai < 2; ++ai)
#pragma unroll
            for (int m = 0; m < 4; ++m) {
                const int row = row0 + ai * HALF + m * 16;
                const f32x4 p0 = *(const f32x4*)(ssq + (size_t)row * 32 + 8 * fq), p1 = *(const f32x4*)(ssq + (size_t)row * 32 + 8 * fq + 4);
                float s = ((p0[0] + p0[1]) + (p0[2] + p0[3])) + ((p1[0] + p1[1]) + (p1[2] + p1[3]));
                s += __shfl_xor(s, 16); s += __shfl_xor(s, 32);
                const float rinv = __builtin_amdgcn_rsqf(s * (1.0f / E_DM) + E_EPS);
                bf16_t* rowp = hid + (size_t)row * E_DFF + col0;
#pragma unroll
                for (int bj = 0; bj < 2; ++bj) {
                    f32x4 v0 = acc[ai][bj][m][0] * rinv, v1 = acc[ai][bj][m][1] * rinv;
#pragma unroll
                    for (int e = 0; e < 4; ++e) { const float a = fmaxf(v0[e], 0.f), b = fmaxf(v1[e], 0.f); v0[e] = a * a; v1[e] = b * b; }
                    u32x4 w; w.x = cvt_pk_bf16(v0[0], v0[1]); w.y = cvt_pk_bf16(v0[2], v0[3]); w.z = cvt_pk_bf16(v1[0], v1[1]); w.w = cvt_pk_bf16(v1[2], v1[3]);
                    *(u32x4*)(rowp + bj * HALF) = w;
                }
            }
    }
};
__device__ __forceinline__ float bf_lo(unsigned u) { return __builtin_bit_cast(float, u << 16); }
__device__ __forceinline__ float bf_hi(unsigned u) { return __builtin_bit_cast(float, u & 0xffff0000u); }
struct Epi5 {
    static constexpr bool PERM = true, AFTER_DRAIN = false;
    bf16_t* x1b; float* ssq;
    __device__ __forceinline__ void operator()(const f32x4 (&acc)[2][2][4][2], const Unit& u, int wr, int wc, int fr, int fq) const {
        const int row0 = u.pm * BM + wr * 64 + fr, col0 = u.pn * BM + wc * 32 + 8 * fq;
#pragma unroll
        for (int ai = 0; ai < 2; ++ai)
#pragma unroll
            for (int m = 0; m < 4; ++m) {
                const int row = row0 + ai * HALF + m * 16; const size_t off = (size_t)row * E_DM + col0; float s = 0.f;
#pragma unroll
                for (int bj = 0; bj < 2; ++bj) {
                    const u32x4 xi = *(const u32x4*)(x1b + off + bj * HALF);
                    const f32x4 o0 = (f32x4){bf_lo(xi.x), bf_hi(xi.x), bf_lo(xi.y), bf_hi(xi.y)} + acc[ai][bj][m][0], o1 = (f32x4){bf_lo(xi.z), bf_hi(xi.z), bf_lo(xi.w), bf_hi(xi.w)} + acc[ai][bj][m][1];
                    s += ((o0[0] * o0[0] + o0[1] * o0[1]) + (o0[2] * o0[2] + o0[3] * o0[3])) + ((o1[0] * o1[0] + o1[1] * o1[1]) + (o1[2] * o1[2] + o1[3] * o1[3]));
                    u32x4 w; w.x = cvt_pk_bf16(o0[0], o0[1]); w.y = cvt_pk_bf16(o0[2], o0[3]); w.z = cvt_pk_bf16(o1[0], o1[1]); w.w = cvt_pk_bf16(o1[2], o1[3]);
                    *(u32x4*)(x1b + off + bj * HALF) = w;
                }
                s += __shfl_xor(s, 16); s += __shfl_xor(s, 32);
                if (fq == 0) ssq[(size_t)row * 32 + u.pn * 4 + wc] = s;
            }
    }
};

template <class Epi, class Sched, bool ALIGN_EPI = false, bool SP2 = false>
__device__ __forceinline__ void gemm_phase(PG8_LAS unsigned char* lds, const Gemm g, const Sched& S, const Epi& E) {
    const int tid = threadIdx.x, wid = __builtin_amdgcn_readfirstlane(tid >> 6), lane = tid & 63, wr = wid >> 2, wc = wid & 3, fr = lane & 15, fq = lane >> 4;
    const int K = g.K, nt = K / BK;
    unsigned voffA[2], voffB[2];
#pragma unroll
    for (int i = 0; i < 2; ++i) { int R, C; stage_rc(tid * 16 + i * 8192, R, C); const int Rb = Epi::PERM ? ((R & ~31) + perm32(R & 31)) : R;
        voffA[i] = (unsigned)(R * K + C) * 2u; voffB[i] = (unsigned)(Rb * K + C) * 2u; }
    const size_t kstep = (size_t)(BK * 2);
    const size_t hstep = (size_t)HALF * K * 2;
    const size_t tstep = 2 * hstep;
    const unsigned ldsw = (unsigned)wid * 1024u;
    const int aoff = lds_byte(wr * 64 + fr, fq * 8), boff = lds_byte(wc * 32 + fr, fq * 8);
#define PG8_SA(b, h) (((b) * 2 + (h)) * HTB)
#define PG8_SB(b, h) ((4 + (b) * 2 + (h)) * HTB)
#define PG8_STAGE(bufoff, gbase, voff) do { _Pragma("unroll") for (int _i = 0; _i < 2; ++_i) \
        __builtin_amdgcn_global_load_lds((const unsigned*)((const char*)(gbase) + (voff)[_i]), (PG8_LAS unsigned*)(lds + (bufoff) + ldsw + _i * 8192), 16, 0, 0); } while (0)
#define PG8_LDA(dst, b, h) do { _Pragma("unroll") for (int m = 0; m < 4; ++m) _Pragma("unroll") for (int k = 0; k < 2; ++k) dst[m][k] = *(const PG8_LAS bf16x8*)(lds + PG8_SA(b, h) + aoff + m * 2048 + k * 1024); } while (0)
#define PG8_LDB(dst, b, h) do { _Pragma("unroll") for (int n = 0; n < 2; ++n) _Pragma("unroll") for (int k = 0; k < 2; ++k) dst[n][k] = *(const PG8_LAS bf16x8*)(lds + PG8_SB(b, h) + boff + n * 2048 + k * 1024); } while (0)
#define PG8_MMA(ai, bj, At, Bt) do { __builtin_amdgcn_s_setprio(1); _Pragma("unroll") for (int m = 0; m < 4; ++m) _Pragma("unroll") for (int n = 0; n < 2; ++n) _Pragma("unroll") for (int k = 0; k < 2; ++k) \
        acc[ai][bj][m][n] = __builtin_amdgcn_mfma_f32_16x16x32_bf16(Bt[n][k], At[m][k], acc[ai][bj][m][n], 0, 0, 0); __builtin_amdgcn_s_setprio(0); } while (0)
#define PG8_WAIT_V(n) asm volatile("s_waitcnt vmcnt(" #n ")" ::: "memory")
#define PG8_WAIT_L(n) asm volatile("s_waitcnt lgkmcnt(" #n ")" ::: "memory")
#define PG8_BAR __builtin_amdgcn_s_barrier()
#define PG8_SCHED __builtin_amdgcn_sched_barrier(0)
    Unit cur, nxt; int ui = 0;
    if (!S.next(0, cur)) return;
    f32x4 acc[2][2][4][2];
#pragma unroll
    for (int a = 0; a < 2; ++a)
#pragma unroll
        for (int b = 0; b < 2; ++b)
#pragma unroll
            for (int m = 0; m < 4; ++m)
#pragma unroll
                for (int n = 0; n < 2; ++n) acc[a][b][m][n] = (f32x4){0.f, 0.f, 0.f, 0.f};
    bf16x8 At[4][2], B0[2][2], B1[2][2];
    const char* cA = (const char*)g.A + (size_t)cur.pm * tstep; const char* cB = (const char*)g.Bt + (size_t)cur.pn * tstep;
    S.a_ready(cur);
    if constexpr (SP2) {
        PG8_STAGE(PG8_SB(0, 0), cB, voffB); PG8_STAGE(PG8_SB(0, 1), cB + hstep, voffB); PG8_STAGE(PG8_SA(0, 0), cA, voffA); PG8_STAGE(PG8_SA(0, 1), cA + hstep, voffA);
        if (wr == 1) PG8_BAR;
        PG8_WAIT_V(2); PG8_BAR;
        PG8_STAGE(PG8_SB(1, 0), cB + kstep, voffB); PG8_STAGE(PG8_SA(1, 0), cA + kstep, voffA); PG8_STAGE(PG8_SB(1, 1), cB + hstep + kstep, voffB);
        PG8_WAIT_V(6); PG8_BAR;
    } else {
        PG8_STAGE(PG8_SB(0, 0), cB, voffB); PG8_STAGE(PG8_SA(0, 0), cA, voffA); PG8_STAGE(PG8_SB(0, 1), cB + hstep, voffB); PG8_STAGE(PG8_SA(0, 1), cA + hstep, voffA);
        if (wr == 1) PG8_BAR;
        PG8_WAIT_V(4); PG8_BAR;
        PG8_STAGE(PG8_SB(1, 0), cB + kstep, voffB); PG8_STAGE(PG8_SA(1, 0), cA + kstep, voffA); PG8_STAGE(PG8_SB(1, 1), cB + hstep + kstep, voffB);
        PG8_WAIT_V(6); PG8_BAR;
    }
    for (;;) {
        const bool has_next = S.next(ui + 1, nxt);
        const char* nA = has_next ? (const char*)g.A + (size_t)nxt.pm * tstep : cA; const char* nB = has_next ? (const char*)g.Bt + (size_t)nxt.pn * tstep : cB;
        for (int t = 0; t < nt; t += 2) {
            const bool last = (t == nt - 2);
            const char* a1 = cA + (size_t)(t + 1) * kstep;
            const char* a2 = last ? nA : cA + (size_t)(t + 2) * kstep; const char* b2 = last ? nB : cB + (size_t)(t + 2) * kstep;
            const char* a3 = a2 + kstep; const char* b3 = b2 + kstep;
            if (last && has_next) S.a_ready(nxt);
            if constexpr (SP2) {
            PG8_LDB(B0, 0, 0); PG8_LDB(B1, 0, 1); PG8_SCHED; PG8_LDA(At, 0, 0); PG8_STAGE(PG8_SA(1, 1), a1 + hstep, voffA);
            PG8_WAIT_V(8); PG8_WAIT_L(0); PG8_BAR; PG8_MMA(0, 0, At, B0); PG8_MMA(0, 1, At, B1); PG8_BAR; PG8_SCHED;
            PG8_LDA(At, 0, 1); PG8_STAGE(PG8_SB(0, 0), b2, voffB); PG8_STAGE(PG8_SB(0, 1), b2 + hstep, voffB); PG8_STAGE(PG8_SA(0, 0), a2, voffA);
            PG8_WAIT_V(8); PG8_WAIT_L(0); PG8_BAR; PG8_MMA(1, 0, At, B0); PG8_MMA(1, 1, At, B1); PG8_BAR; PG8_SCHED;
            PG8_LDB(B0, 1, 0); PG8_LDB(B1, 1, 1); PG8_SCHED; PG8_LDA(At, 1, 0); PG8_STAGE(PG8_SA(0, 1), a2 + hstep, voffA);
            PG8_WAIT_V(8); PG8_WAIT_L(0); PG8_BAR; PG8_MMA(0, 0, At, B0); PG8_MMA(0, 1, At, B1); PG8_BAR; PG8_SCHED;
            PG8_LDA(At, 1, 1); PG8_STAGE(PG8_SB(1, 0), b3, voffB); PG8_STAGE(PG8_SB(1, 1), b3 + hstep, voffB); PG8_STAGE(PG8_SA(1, 0), a3, voffA);
            PG8_WAIT_V(8); PG8_WAIT_L(0); PG8_BAR; PG8_MMA(1, 0, At, B0); PG8_MMA(1, 1, At, B1); PG8_BAR; PG8_SCHED;
            } else {
            PG8_LDB(B0, 0, 0); PG8_SCHED; PG8_LDA(At, 0, 0); PG8_STAGE(PG8_SA(1, 1), a1 + hstep, voffA);
            PG8_WAIT_L(8); PG8_BAR; PG8_WAIT_L(0); PG8_MMA(0, 0, At, B0); PG8_BAR; PG8_SCHED;
            PG8_LDB(B1, 0, 1); PG8_STAGE(PG8_SB(0, 0), b2, voffB);
            PG8_BAR; PG8_WAIT_L(0); PG8_MMA(0, 1, At, B1); PG8_BAR;
            PG8_LDA(At, 0, 1); PG8_STAGE(PG8_SA(0, 0), a2, voffA);
            PG8_BAR; PG8_WAIT_L(0); PG8_MMA(1, 0, At, B0); PG8_BAR; PG8_SCHED;
            PG8_STAGE(PG8_SB(0, 1), b2 + hstep, voffB);
            PG8_WAIT_V(6); PG8_BAR; PG8_MMA(1, 1, At, B1); PG8_BAR;
            PG8_LDB(B0, 1, 0); PG8_SCHED; PG8_LDA(At, 1, 0); PG8_STAGE(PG8_SA(0, 1), a2 + hstep, voffA);
            PG8_WAIT_L(8); PG8_BAR; PG8_WAIT_L(0); PG8_MMA(0, 0, At, B0); PG8_BAR; PG8_SCHED;
            PG8_LDB(B1, 1, 1); PG8_STAGE(PG8_SB(1, 0), b3, voffB);
            PG8_BAR; PG8_WAIT_L(0); PG8_MMA(0, 1, At, B1); PG8_BAR;
            PG8_LDA(At, 1, 1); PG8_STAGE(PG8_SA(1, 0), a3, voffA);
            PG8_BAR; PG8_WAIT_L(0); PG8_MMA(1, 0, At, B0); PG8_BAR; PG8_SCHED;
            PG8_STAGE(PG8_SB(1, 1), b3 + hstep, voffB);
            PG8_WAIT_V(6); PG8_BAR; PG8_MMA(1, 1, At, B1); PG8_BAR;
            }
        }
        if constexpr (ALIGN_EPI) { if (wr == 0) PG8_BAR; }
        if constexpr (!Epi::AFTER_DRAIN) { E(acc, cur, wr, wc, fr, fq); S.done(cur); }
        if (!has_next) break;
#pragma unroll
        for (int a = 0; a < 2; ++a)
#pragma unroll
            for (int b = 0; b < 2; ++b)
#pragma unroll
                for (int m = 0; m < 4; ++m)
#pragma unroll
                    for (int n = 0; n < 2; ++n) acc[a][b][m][n] = (f32x4){0.f, 0.f, 0.f, 0.f};
        cur = nxt; cA = nA; cB = nB; ++ui;
        if constexpr (ALIGN_EPI) { if (wr == 1) PG8_BAR; }
    }
    PG8_WAIT_V(0);
    if constexpr (!ALIGN_EPI) { if (wr == 0) PG8_BAR; }
    PG8_BAR;
    if constexpr (Epi::AFTER_DRAIN) { E.fused(acc, cur, wr, wc, fr, fq, lds, wid, lane); S.done(cur); }
#undef PG8_SA
#undef PG8_SB
#undef PG8_STAGE
#undef PG8_LDA
#undef PG8_LDB
#undef PG8_MMA
#undef PG8_WAIT_V
#undef PG8_WAIT_L
#undef PG8_BAR
#undef PG8_SCHED
}
}

constexpr int NWAVES = 8;
constexpr int NB = 8, SEQ = 2048, DM = 2048, M = NB * SEQ;
constexpr int DSGU = 768, DCONV = 768, DMEM = 512, DIN = 4352, DFF = 8192, NMEM = 256, HD = 128, CHUNK = 128;
constexpr int OFF_U = 0, OFF_V = 768, OFF_B = 1536, OFF_C = 2304, OFF_X = 3072, OFF_Q = 3840;
constexpr float EPS = 1e-6f;
constexpr float QSCALE = 0.08838834764831845f * 1.4426950408889634f;
#ifndef MK_N_LAUNCHES
#define MK_N_LAUNCHES 1
#endif
constexpr int N_PHASES = 7;
constexpr int N_LAUNCHES = MK_N_LAUNCHES;

constexpr size_t MiB = 1u << 20;
constexpr size_t WS_CTL = 0, CTL_ZERO_BYTES = 64 * 1024;
constexpr size_t WS_VSTATS = 1 * MiB;
constexpr size_t WS_SSQ1 = 3 * MiB;
constexpr size_t WS_SSQ2 = 5 * MiB;
constexpr size_t WS_WO = 8 * MiB;
constexpr size_t WS_W1 = 16 * MiB;
constexpr size_t WS_W2 = 48 * MiB;
constexpr size_t WS_KMAT = 80 * MiB;
constexpr size_t WS_VT = 82 * MiB;
constexpr size_t WS_BIG = 84 * MiB;
constexpr size_t WS_XN = WS_BIG, WS_MEMN = WS_BIG + 64 * MiB, WS_WIN = WS_BIG + 72 * MiB, WS_WKV = WS_BIG + 89 * MiB;
constexpr size_t WS_X1B = WS_XN;
constexpr size_t WS_PROJ = 180 * MiB;
constexpr size_t WS_HEADS = 316 * MiB;
constexpr size_t WS_HID = 180 * MiB;
constexpr size_t WS_END = 436 * MiB;
constexpr int CW_BAR = 1024;

constexpr int SCRATCH_BYTES = 139264;
constexpr int MISC_OFF = SCRATCH_BYTES;
constexpr int LDS_BYTES = 147456;

#define GAS __attribute__((address_space(1)))
#define LAS __attribute__((address_space(3)))
typedef unsigned short bf16;
typedef unsigned v4u __attribute__((ext_vector_type(4)));
typedef float f32x4 __attribute__((ext_vector_type(4)));
typedef short bf16x8 __attribute__((ext_vector_type(8)));
typedef GAS unsigned gu32;
typedef GAS unsigned long long gu64;
#define RLX_AGENT __ATOMIC_RELAXED, __HIP_MEMORY_SCOPE_AGENT
#define LDS_WAIT() asm volatile("s_waitcnt lgkmcnt(0)" ::: "memory")
#define VM_WAIT() asm volatile("s_waitcnt vmcnt(0)" ::: "memory")
__device__ __forceinline__ unsigned long long rt() { return __builtin_amdgcn_s_memrealtime(); }
__device__ __forceinline__ unsigned f2bf(float f) { unsigned u = __builtin_bit_cast(unsigned, f); return (u + 0x7fffu + ((u >> 16) & 1u)) >> 16; }
__device__ __forceinline__ unsigned pk2(float lo, float hi) { return f2bf(lo) | (f2bf(hi) << 16); }

#define XB_TMO      128
#define XB_XCNT(j)  (256  + 64 * (j))
#define XB_XSUB(j)  (1280 + 64 * (j))
#define XB_XGEN(j)  (2304 + 64 * (j))
#define XB_TOP      3328
#define XB_TOPGEN   3392
#define XCD_BAR_WORDS 3456
#define XB_SPIN_CAP (1u << 18)

__device__ __forceinline__ unsigned xb_ld(unsigned* p)              { return __hip_atomic_load(p, __ATOMIC_RELAXED, __HIP_MEMORY_SCOPE_AGENT); }
__device__ __forceinline__ unsigned xb_add(unsigned* p, unsigned v) { return __hip_atomic_fetch_add(p, v, __ATOMIC_RELAXED, __HIP_MEMORY_SCOPE_AGENT); }
__device__ __forceinline__ unsigned xb_xcc_id() { return (unsigned)__builtin_amdgcn_s_getreg((3 << 11) | 20) & 0xFu; }
#define XB_SPIN(cond, bar) do { unsigned _sp = 0; while (cond) { __builtin_amdgcn_s_sleep(1); \
    if ((++_sp & 255u) == 0u) { if (xb_ld(&(bar)[XB_TMO])) break; if (_sp > XB_SPIN_CAP) { atomicAdd(&(bar)[XB_TMO], 1u); break; } } } } while (0)

struct XcdBarrier {
    unsigned* bar; unsigned x;
    volatile LAS unsigned* st;
};

__device__ __forceinline__ XcdBarrier xcd_barrier_post(unsigned* bar, volatile LAS unsigned* st) {
    XcdBarrier b; b.bar = bar; b.x = xb_xcc_id(); b.st = st;
    if (threadIdx.x == 0) (void)xb_add(&bar[XB_XCNT(b.x)], 1u);
    return b;
}
__device__ __forceinline__ void xcd_barrier_complete(unsigned* bar, unsigned x, unsigned& nloc, unsigned& nx) {
    const unsigned G = gridDim.x * gridDim.y * gridDim.z;
    unsigned sum, cnt, mine, sp = 0u;
    for (;;) {
        sum = 0u; cnt = 0u; mine = 0u;
#pragma unroll
        for (unsigned j = 0; j < 16; ++j) { const unsigned c = xb_ld(&bar[XB_XCNT(j)]); sum += c; cnt += (c > 0u) ? 1u : 0u; mine = (j == x) ? c : mine; }
        if (sum == G) break;
        __builtin_amdgcn_s_sleep(1);
        if ((++sp & 255u) == 0u) { if (xb_ld(&bar[XB_TMO])) break; if (sp > XB_SPIN_CAP) { atomicAdd(&bar[XB_TMO], 1u); break; } }
    }
    nloc = mine > 0u ? mine : 1u; nx = cnt > 0u ? cnt : 1u;
}

__device__ __forceinline__ void xcd_barrier(const XcdBarrier& b) {
    asm volatile("s_waitcnt vmcnt(0)" ::: "memory");
    __syncthreads();
    if (threadIdx.x == 0) {
        unsigned* bar = b.bar;
        __builtin_amdgcn_s_waitcnt(0);
        unsigned nloc = b.st[0], nx = b.st[1];
        if (nloc == 0u) { xcd_barrier_complete(bar, b.x, nloc, nx); b.st[0] = nloc; b.st[1] = nx; }
        const unsigned old = xb_add(&bar[XB_XSUB(b.x)], 1u);
        const unsigned gen = old / nloc;
        if (old + 1u == (gen + 1u) * nloc) {
            __builtin_amdgcn_fence(__ATOMIC_RELEASE, "agent");
            asm volatile("s_waitcnt vmcnt(0)" ::: "memory");
            const unsigned og = xb_add(&bar[XB_TOP], 1u);
            const unsigned tg = og / nx;
            if (og + 1u == (tg + 1u) * nx) xb_add(&bar[XB_TOPGEN], 1u);
            else XB_SPIN(xb_ld(&bar[XB_TOPGEN]) == tg, bar);
            __builtin_amdgcn_fence(__ATOMIC_ACQUIRE, "agent");
            xb_add(&bar[XB_XGEN(b.x)], 1u);
            asm volatile("s_waitcnt vmcnt(0)" ::: "memory");
        } else {
            XB_SPIN(xb_ld(&bar[XB_XGEN(b.x)]) == gen, bar);
            __builtin_amdgcn_fence(__ATOMIC_ACQUIRE, "agent");
            asm volatile("s_waitcnt vmcnt(0)" ::: "memory");
        }
    }
    __syncthreads();
}

typedef unsigned v2u __attribute__((ext_vector_type(2)));
typedef float f32x2 __attribute__((ext_vector_type(2)));
typedef short bf16x4 __attribute__((ext_vector_type(4)));
__device__ __forceinline__ float bflo(unsigned u) { return __builtin_bit_cast(float, u << 16); }
__device__ __forceinline__ float bfhi(unsigned u) { return __builtin_bit_cast(float, u & 0xffff0000u); }
__device__ __forceinline__ void unpack8(const v4u w, float (&f)[8]) { f[0] = bflo(w.x); f[1] = bfhi(w.x); f[2] = bflo(w.y); f[3] = bfhi(w.y); f[4] = bflo(w.z); f[5] = bfhi(w.z); f[6] = bflo(w.w); f[7] = bfhi(w.w); }


struct Args {
    const float *x, *mem, *g_mix, *w_in, *ln_g, *ln_b, *w_s, *b_s, *conv_w, *g_mem, *w_kv, *g_head, *w_o, *g_ffn, *w1, *w2, *g_final;
    float* out; unsigned char* ws; int ph_lo, ph_hi;
};

__device__ __forceinline__ float wave_sum(float v) {
#pragma unroll
    for (int o = 1; o < 64; o <<= 1) v += __shfl_xor(v, o);
    return v;
}
__device__ __forceinline__ void p0_transpose_item(const float* W, int K, int N, bf16* WT, const float* ks, LAS unsigned* scr, int item, int lane) {
    const int nblk = N / 64, kb = item / nblk, nb = item % nblk, k0 = 64 * kb, n0 = 64 * nb;
    const int n4 = (lane & 15) * 4, kr2 = lane >> 4;
    f32x4 a[8], b[8];
#pragma unroll
    for (int i = 0; i < 8; ++i) { const float* p = W + (size_t)(k0 + 8 * i + 2 * kr2) * N + n0 + n4; a[i] = *(const GAS f32x4*)p; b[i] = *(const GAS f32x4*)(p + N); }
    if (ks) {
#pragma unroll
        for (int i = 0; i < 8; ++i) { const float s0 = ks[k0 + 8 * i + 2 * kr2], s1 = ks[k0 + 8 * i + 2 * kr2 + 1]; a[i] = a[i] * s0; b[i] = b[i] * s1; }
    }
#pragma unroll
    for (int i = 0; i < 8; ++i) { LAS unsigned* d = scr + n4 * 33 + 4 * i + kr2;
        d[0] = pg8::cvt_pk_bf16(a[i].x, b[i].x); d[33] = pg8::cvt_pk_bf16(a[i].y, b[i].y); d[66] = pg8::cvt_pk_bf16(a[i].z, b[i].z); d[99] = pg8::cvt_pk_bf16(a[i].w, b[i].w); }
    LDS_WAIT(); asm volatile("" ::: "memory");
    const int c = lane & 7;
#pragma unroll
    for (int j = 0; j < 8; ++j) { const int n = (lane >> 3) + 8 * j; const LAS unsigned* sp = scr + n * 33 + 4 * c;
        v4u o; o.x = sp[0]; o.y = sp[1]; o.z = sp[2]; o.w = sp[3];
        *(GAS v4u*)(WT + (size_t)(n0 + n) * K + k0 + 8 * c) = o; }
    LDS_WAIT(); asm volatile("" ::: "memory");
}
__device__ __forceinline__ void rms_row_to_bf16(const float* xrow, const float* gain, bf16* orow, int lane) {
    const GAS f32x4* xr = (const GAS f32x4*)xrow + lane; const GAS f32x4* gr = (const GAS f32x4*)gain + lane;
    f32x4 v[8]; float s = 0.f;
#pragma unroll
    for (int j = 0; j < 8; ++j) { v[j] = xr[64 * j]; s += (v[j].x * v[j].x + v[j].y * v[j].y) + (v[j].z * v[j].z + v[j].w * v[j].w); }
    const float rinv = 1.0f / sqrtf(wave_sum(s) * (1.f / DM) + EPS);
    GAS v2u* o8 = (GAS v2u*)orow + lane;
#pragma unroll
    for (int j = 0; j < 8; ++j) { const f32x4 g = gr[64 * j]; v2u o; o.x = pk2(v[j].x * rinv * g.x, v[j].y * rinv * g.y); o.y = pk2(v[j].z * rinv * g.z, v[j].w * rinv * g.w); o8[64 * j] = o; }
}

__device__ __forceinline__ void head_norm_store(float (&v)[4][8], size_t row, int hcol0, int g, const float* g_head, bf16* heads) {
    float s = 0.f;
#pragma unroll
    for (int p = 0; p < 4; ++p)
#pragma unroll
        for (int e = 0; e < 8; ++e) s += v[p][e] * v[p][e];
    s += __shfl_xor(s, 16); s += __shfl_xor(s, 32);
    const float rinv = 1.0f / sqrtf(s * (1.f / HD) + EPS);
#pragma unroll
    for (int p = 0; p < 4; ++p) {
        const int c = hcol0 + 32 * p + 8 * g;
        const f32x4 g0 = *(const GAS f32x4*)(g_head + c), g1 = *(const GAS f32x4*)(g_head + c + 4);
        v4u w; w.x = pk2(v[p][0] * rinv * g0.x, v[p][1] * rinv * g0.y); w.y = pk2(v[p][2] * rinv * g0.z, v[p][3] * rinv * g0.w);
        w.z = pk2(v[p][4] * rinv * g1.x, v[p][5] * rinv * g1.y); w.w = pk2(v[p][6] * rinv * g1.z, v[p][7] * rinv * g1.w);
        *(GAS v4u*)(heads + row * DM + c) = w;
    }
}

constexpr int VROW = 272;
constexpr int KROW = 272;
constexpr int VTROW = 528;
constexpr int K_BYTES = 256 * KROW;
static_assert(K_BYTES + 128 * VTROW <= SCRATCH_BYTES, "attention tiles fit the scratch");

__device__ __forceinline__ void sgu_unit(const Args& A, LAS unsigned char* lds, int R0, int h, int tid) {
    const bf16* proj = (const bf16*)(A.ws + WS_PROJ); const float* vstats = (const float*)(A.ws + WS_VSTATS); bf16* heads = (bf16*)(A.ws + WS_HEADS);
    const int lane = tid & 63, w = __builtin_amdgcn_readfirstlane(tid >> 6), fr = lane & 15, g = lane >> 4;
    {
        const int sp = tid >> 3, dc = tid & 7, d0 = 16 * dc;
        float mean[2], rstd[2];
#pragma unroll
        for (int r = 0; r < 2; ++r) {
            const GAS f32x4* st = (const GAS f32x4*)(vstats + (size_t)(R0 + 2 * sp + r) * 24);
            float s1 = 0.f, s2 = 0.f;
#pragma unroll
            for (int i = 0; i < 6; ++i) { const f32x4 t = st[i]; s1 += t.x + t.z; s2 += t.y + t.w; }
            mean[r] = s1 * (1.f / DSGU); const float var = s2 * (1.f / DSGU) - mean[r] * mean[r]; rstd[r] = 1.0f / sqrtf(fmaxf(var, 0.f) + EPS);
        }
        float val[2][16];
#pragma unroll
        for (int r = 0; r < 2; ++r) {
            const GAS v4u* src = (const GAS v4u*)(proj + (size_t)(R0 + 2 * sp + r) * DIN + OFF_V + h * HD + d0);
            float f0[8], f1[8]; unpack8(src[0], f0); unpack8(src[1], f1);
#pragma unroll
            for (int e = 0; e < 8; ++e) { val[r][e] = (f0[e] - mean[r]) * rstd[r]; val[r][8 + e] = (f1[e] - mean[r]) * rstd[r]; }
        }
#pragma unroll
        for (int q = 0; q < 4; ++q) {
            const f32x4 lg = *(const GAS f32x4*)(A.ln_g + h * HD + d0 + 4 * q), lb = *(const GAS f32x4*)(A.ln_b + h * HD + d0 + 4 * q);
#pragma unroll
            for (int e = 0; e < 4; ++e) {
                const int i = 4 * q + e;
                const float a = val[0][i] * lg[e] + lb[e], b = val[1][i] * lg[e] + lb[e];
                *(LAS unsigned*)(lds + (d0 + i) * VROW + 4 * sp) = pk2(a, b);
            }
        }
    }
    __syncthreads();
    f32x4 acc[4][2];
#pragma unroll
    for (int p = 0; p < 4; ++p)
#pragma unroll
        for (int q = 0; q < 2; ++q) acc[p][q] = (f32x4){0.f, 0.f, 0.f, 0.f};
    const int t = 16 * w + fr;
    const int nks = (w >> 1) + 1;
    const float* wrow = A.w_s + ((size_t)h * CHUNK + t) * CHUNK;
    for (int ks = 0; ks < nks; ++ks) {
        const int s0 = 32 * ks + 8 * g;
        const f32x4 w0 = *(const GAS f32x4*)(wrow + s0), w1 = *(const GAS f32x4*)(wrow + s0 + 4);
        float wf[8] = {w0.x, w0.y, w0.z, w0.w, w1.x, w1.y, w1.z, w1.w};
#pragma unroll
        for (int e = 0; e < 8; ++e) wf[e] = (s0 + e <= t) ? wf[e] : 0.f;
        v4u bw; bw.x = pk2(wf[0], wf[1]); bw.y = pk2(wf[2], wf[3]); bw.z = pk2(wf[4], wf[5]); bw.w = pk2(wf[6], wf[7]);
        const bf16x8 bfrag = __builtin_bit_cast(bf16x8, bw);
#pragma unroll
        for (int p = 0; p < 4; ++p)
#pragma unroll
            for (int q = 0; q < 2; ++q) {
                const int drow = 32 * p + 8 * (fr >> 2) + 4 * q + (fr & 3);
                const bf16x8 afrag = *(const LAS bf16x8*)(lds + drow * VROW + 64 * ks + 16 * g);
                acc[p][q] = __builtin_amdgcn_mfma_f32_16x16x32_bf16(afrag, bfrag, acc[p][q], 0, 0, 0);
            }
    }
    const float bias = A.b_s[h * CHUNK + t];
    float v[4][8];
#pragma unroll
    for (int p = 0; p < 4; ++p) {
        float gu[8]; unpack8(*(const GAS v4u*)(proj + (size_t)(R0 + t) * DIN + OFF_U + h * HD + 32 * p + 8 * g), gu);
#pragma unroll
        for (int q = 0; q < 2; ++q)
#pragma unroll
            for (int e = 0; e < 4; ++e) v[p][4 * q + e] = gu[4 * q + e] * (acc[p][q][e] + bias);
    }
    head_norm_store(v, (size_t)(R0 + t), h * HD, g, A.g_head, heads);
    __syncthreads();
}

__device__ __forceinline__ void conv_unit(const Args& A, int R0, int tpos0, int grp, int tid) {
    const bf16* proj = (const bf16*)(A.ws + WS_PROJ); bf16* heads = (bf16*)(A.ws + WS_HEADS);
    const int lane = tid & 63, w = tid >> 6, fr = lane & 15, g = lane >> 4;
    const int t = 16 * w + fr; const size_t row = (size_t)(R0 + t); const int tpos = tpos0 + t;
    float v[4][8];
#pragma unroll
    for (int p = 0; p < 4; ++p) {
        const int col = grp * HD + 32 * p + 8 * g;
        float y[8];
#pragma unroll
        for (int e = 0; e < 8; ++e) y[e] = 0.f;
#pragma unroll
        for (int k = 0; k < 3; ++k) {
            const int back = 2 - k;
            if (tpos - back >= 0) {
                float c[8], xin[8];
                unpack8(*(const GAS v4u*)(proj + (row - back) * DIN + OFF_C + col), c);
                unpack8(*(const GAS v4u*)(proj + (row - back) * DIN + OFF_X + col), xin);
                const f32x4 k0 = *(const GAS f32x4*)(A.conv_w + k * DCONV + col), k1 = *(const GAS f32x4*)(A.conv_w + k * DCONV + col + 4);
                const float kw[8] = {k0.x, k0.y, k0.z, k0.w, k1.x, k1.y, k1.z, k1.w};
#pragma unroll
                for (int e = 0; e < 8; ++e) y[e] += kw[e] * (c[e] * xin[e]);
            }
        }
        float bg[8]; unpack8(*(const GAS v4u*)(proj + row * DIN + OFF_B + col), bg);
#pragma unroll
        for (int e = 0; e < 8; ++e) v[p][e] = bg[e] * y[e];
    }
    head_norm_store(v, row, DSGU + grp * HD, g, A.g_head, heads);
}

__device__ __forceinline__ void attn_stage(const Args& A, LAS unsigned char* lds, int b, int h, int tid) {
    const bf16* kmat = (const bf16*)(A.ws + WS_KMAT); const bf16* vt = (const bf16*)(A.ws + WS_VT);
#pragma unroll
    for (int it = 0; it < 8; ++it) {
        const int idx = tid + 512 * it;
        { const int key = idx >> 4, ch = idx & 15; const v4u d = *(const GAS v4u*)(kmat + (size_t)(b * NMEM + key) * DMEM + h * HD + 8 * ch); *(LAS v4u*)(lds + key * KROW + 16 * ch) = d; }
        { const int dd = idx >> 5, ch = idx & 31; const v4u d = *(const GAS v4u*)(vt + (size_t)(h * HD + dd) * (NB * NMEM) + b * NMEM + 8 * ch); *(LAS v4u*)(lds + K_BYTES + dd * VTROW + 16 * ch) = d; }
    }
}
__device__ __forceinline__ void attn_chunk(const Args& A, LAS unsigned char* lds, int R0, int h, int tid) {
    const bf16* proj = (const bf16*)(A.ws + WS_PROJ); bf16* heads = (bf16*)(A.ws + WS_HEADS);
    const int lane = tid & 63, w = tid >> 6, fr = lane & 15, g = lane >> 4;
    const size_t row = (size_t)(R0 + 16 * w + fr);
    bf16x8 qf[4];
#pragma unroll
    for (int ks = 0; ks < 4; ++ks) qf[ks] = __builtin_bit_cast(bf16x8, *(const GAS v4u*)(proj + row * DIN + OFF_Q + h * HD + 32 * ks + 8 * g));
    f32x4 sacc[16];
    bf16x8 kf[2][4];
#pragma unroll
    for (int ks = 0; ks < 4; ++ks) kf[0][ks] = *(const LAS bf16x8*)(lds + fr * KROW + 64 * ks + 16 * g);
#pragma unroll
    for (int kt = 0; kt < 16; ++kt) {
        if (kt + 1 < 16) {
#pragma unroll
            for (int ks = 0; ks < 4; ++ks) kf[(kt + 1) & 1][ks] = *(const LAS bf16x8*)(lds + (16 * (kt + 1) + fr) * KROW + 64 * ks + 16 * g);
        }
        sacc[kt] = (f32x4){0.f, 0.f, 0.f, 0.f};
#pragma unroll
        for (int ks = 0; ks < 4; ++ks) sacc[kt] = __builtin_amdgcn_mfma_f32_16x16x32_bf16(kf[kt & 1][ks], qf[ks], sacc[kt], 0, 0, 0);
        asm volatile("" ::: "memory");
    }
    float mx = -3.0e38f;
#pragma unroll
    for (int kt = 0; kt < 16; ++kt) mx = fmaxf(mx, fmaxf(fmaxf(sacc[kt][0], sacc[kt][1]), fmaxf(sacc[kt][2], sacc[kt][3])));
    mx = fmaxf(mx, __shfl_xor(mx, 16)); mx = fmaxf(mx, __shfl_xor(mx, 32));
    float l = 0.f;
#pragma unroll
    for (int kt = 0; kt < 16; ++kt)
#pragma unroll
        for (int e = 0; e < 4; ++e) { const float p = __builtin_amdgcn_exp2f(sacc[kt][e] - mx); sacc[kt][e] = p; l += p; }
    l += __shfl_xor(l, 16); l += __shfl_xor(l, 32);
    f32x4 oacc[4][2];
#pragma unroll
    for (int p = 0; p < 4; ++p)
#pragma unroll
        for (int q = 0; q < 2; ++q) oacc[p][q] = (f32x4){0.f, 0.f, 0.f, 0.f};
    v4u af[2][4][2];
    const LAS unsigned char* vbase = lds + K_BYTES + (8 * (fr >> 2) + (fr & 3)) * VTROW + 8 * g;
#define LOAD_AF(buf, s_) do { _Pragma("unroll") for (int p = 0; p < 4; ++p) _Pragma("unroll") for (int q = 0; q < 2; ++q) { \
        const LAS unsigned char* a0 = vbase + (32 * p + 4 * q) * VTROW + 64 * (s_); const v2u lo_ = *(const LAS v2u*)a0, hi_ = *(const LAS v2u*)(a0 + 32); \
        af[buf][p][q] = (v4u){lo_.x, lo_.y, hi_.x, hi_.y}; } } while (0)
    LOAD_AF(0, 0);
#pragma unroll
    for (int s = 0; s < 8; ++s) {
        if (s + 1 < 8) LOAD_AF((s + 1) & 1, s + 1);
        v4u pw; pw.x = pk2(sacc[2 * s][0], sacc[2 * s][1]); pw.y = pk2(sacc[2 * s][2], sacc[2 * s][3]); pw.z = pk2(sacc[2 * s + 1][0], sacc[2 * s + 1][1]); pw.w = pk2(sacc[2 * s + 1][2], sacc[2 * s + 1][3]);
        const bf16x8 pf = __builtin_bit_cast(bf16x8, pw);
#pragma unroll
        for (int p = 0; p < 4; ++p)
#pragma unroll
            for (int q = 0; q < 2; ++q)
                oacc[p][q] = __builtin_amdgcn_mfma_f32_16x16x32_bf16(__builtin_bit_cast(bf16x8, af[s & 1][p][q]), pf, oacc[p][q], 0, 0, 0);
        asm volatile("" ::: "memory");
    }
#undef LOAD_AF
    const float linv = 1.0f / l;
    float v[4][8];
#pragma unroll
    for (int p = 0; p < 4; ++p)
#pragma unroll
        for (int q = 0; q < 2; ++q)
#pragma unroll
            for (int e = 0; e < 4; ++e) v[p][4 * q + e] = oacc[p][q][e] * linv;
    head_norm_store(v, row, DSGU + DCONV + h * HD, g, A.g_head, heads);
}

__global__ void __launch_bounds__(NWAVES * 64, 2) fwd_kernel(Args args) {
    extern __shared__ __attribute__((aligned(16))) unsigned char lds_raw[];
    LAS unsigned char* lds = (LAS unsigned char*)lds_raw;
    volatile LAS unsigned* MISC = (volatile LAS unsigned*)(lds + MISC_OFF);
    const int tid = threadIdx.x, lane = tid & 63, wave = __builtin_amdgcn_readfirstlane(tid >> 6);
    const int G = gridDim.x, bx = blockIdx.x;
    const int vcu = (G % 8 == 0) ? (bx % 8) * (G / 8) + bx / 8 : bx;
    unsigned char* ws = args.ws;
    for (int u = tid; u < (LDS_BYTES - MISC_OFF) / 4; u += NWAVES * 64) ((LAS unsigned*)(lds + MISC_OFF))[u] = 0u;
    __syncthreads();
    XcdBarrier bar; bar.bar = (unsigned*)(ws + WS_CTL) + CW_BAR; bar.x = 0; bar.st = nullptr;
    if (N_LAUNCHES == 1) bar = xcd_barrier_post((unsigned*)(ws + WS_CTL) + CW_BAR, MISC + 8);
    const int lo = args.ph_lo, hi = args.ph_hi;
#define IN(k) (lo <= (k) && (k) < hi)
#define SEAM(k) do { if (IN(k) && IN((k) + 1)) xcd_barrier(bar); } while (0)
    bf16* BIG = (bf16*)(ws + WS_BIG);

    if (IN(0)) {
        LAS unsigned* scr = (LAS unsigned*)(lds + wave * 16384);
        const int gw = vcu * NWAVES + wave, NGW = G * NWAVES;
        constexpr int I_IN = (DM / 64) * (DIN / 64), I_KV = (DM / 64) * (2 * DMEM / 64), I_O = (DM / 64) * (DM / 64), I_1 = (DM / 64) * (DFF / 64), I_2 = (DFF / 64) * (DM / 64);
        constexpr int NITEMS = I_IN + I_KV + I_O + I_1 + I_2;
        for (int it = gw; it < NITEMS; it += NGW) {
            int r = it;
            if (r < I_IN) { p0_transpose_item(args.w_in, DM, DIN, (bf16*)(ws + WS_WIN), nullptr, scr, r, lane); continue; } r -= I_IN;
            if (r < I_KV) { p0_transpose_item(args.w_kv, DM, 2 * DMEM, (bf16*)(ws + WS_WKV), nullptr, scr, r, lane); continue; } r -= I_KV;
            if (r < I_O) { p0_transpose_item(args.w_o, DM, DM, (bf16*)(ws + WS_WO), nullptr, scr, r, lane); continue; } r -= I_O;
            if (r < I_1) { p0_transpose_item(args.w1, DM, DFF, (bf16*)(ws + WS_W1), args.g_ffn, scr, r, lane); continue; } r -= I_1;
            p0_transpose_item(args.w2, DFF, DM, (bf16*)(ws + WS_W2), nullptr, scr, r, lane);
        }
        for (int m = gw; m < M + NB * NMEM; m += NGW) {
            if (m < M) rms_row_to_bf16(args.x + (size_t)m * DM, args.g_mix, (bf16*)(ws + WS_XN) + (size_t)m * DM, lane);
            else rms_row_to_bf16(args.mem + (size_t)(m - M) * DM, args.g_mem, (bf16*)(ws + WS_MEMN) + (size_t)(m - M) * DM, lane);
        }
    }
    SEAM(0);
    if (IN(1)) {
        pg8::Gemm g{BIG, BIG, 0, 0, DM}; pg8::Order1 S; S.init(G, bx);
        pg8::Epi1 E{(bf16*)(ws + WS_PROJ), (bf16*)(ws + WS_KMAT), (bf16*)(ws + WS_VT), (float*)(ws + WS_VSTATS), QSCALE};
        pg8::gemm_phase<pg8::Epi1, pg8::Order1, true, true>(lds, g, S, E);
    }
    SEAM(1);
    if (IN(2)) {
        for (int s = bx; s < 768; s += G) { const int h = s % 6, bc = s / 6; sgu_unit(args, lds, bc * CHUNK, h, tid); }
        for (int s = bx; s < 768; s += G) { const int grp = s % 6, bc = s / 6; conv_unit(args, bc * CHUNK, (bc & 15) * CHUNK, grp, tid); }
        for (int a = vcu; a < 256; a += G) {
            const int bh = a >> 3, cp = a & 7, b = bh >> 2, h = bh & 3;
            attn_stage(args, lds, b, h, tid);
            __syncthreads();
#pragma unroll 1
            for (int r = 0; r < 2; ++r) attn_chunk(args, lds, b * SEQ + (cp + 8 * r) * CHUNK, h, tid);
            __syncthreads();
        }
    }
    SEAM(2);
    if (IN(3)) {
        pg8::Gemm g{(const bf16*)(ws + WS_HEADS), (const bf16*)(ws + WS_WO), M, DM, DM}; pg8::StaticOrder S; S.init(M, DM, G, bx);
        pg8::Epi3 E{args.x, (bf16*)(ws + WS_X1B), (float*)(ws + WS_SSQ1)};
        pg8::gemm_phase<pg8::Epi3, pg8::StaticOrder, true, true>(lds, g, S, E);
    }
    SEAM(3);
    if (IN(4)) {
        pg8::Gemm g{(const bf16*)(ws + WS_X1B), (const bf16*)(ws + WS_W1), M, DFF, DM}; pg8::StaticOrder S; S.init(M, DFF, G, bx);
        pg8::Epi4 E{(bf16*)(ws + WS_HID), (const float*)(ws + WS_SSQ1)};
        pg8::gemm_phase<pg8::Epi4, pg8::StaticOrder, true, true>(lds, g, S, E);
    }
    SEAM(4);
    if (IN(5)) {
        pg8::Gemm g{(const bf16*)(ws + WS_HID), (const bf16*)(ws + WS_W2), M, DM, DFF}; pg8::StaticOrder S; S.init(M, DM, G, bx);
        pg8::Epi5 E{(bf16*)(ws + WS_X1B), (float*)(ws + WS_SSQ2)};
        pg8::gemm_phase<pg8::Epi5, pg8::StaticOrder, true, true>(lds, g, S, E);
    }
    SEAM(5);
    if (IN(6)) {
        const int gw = bx * NWAVES + wave, NGW = G * NWAVES;
        const float* ssq2 = (const float*)(ws + WS_SSQ2);
        for (int m = gw; m < M; m += NGW) {
            const float part = lane < 32 ? ssq2[(size_t)m * 32 + lane] : 0.f;
            const float rinv = 1.0f / sqrtf(wave_sum(part) * (1.f / DM) + EPS);
            const GAS v4u* xr = (const GAS v4u*)((const bf16*)(ws + WS_X1B) + (size_t)m * DM) + lane;
            GAS f32x4* ow = (GAS f32x4*)(args.out + (size_t)m * DM) + 2 * lane; const GAS f32x4* gr = (const GAS f32x4*)args.g_final + 2 * lane;
            v4u v[4];
#pragma unroll
            for (int j = 0; j < 4; ++j) v[j] = xr[64 * j];
#pragma unroll
            for (int j = 0; j < 4; ++j) {
                float f[8]; unpack8(v[j], f); const f32x4 g0 = gr[128 * j], g1 = gr[128 * j + 1];
                ow[128 * j] = (f32x4){f[0] * rinv * g0.x, f[1] * rinv * g0.y, f[2] * rinv * g0.z, f[3] * rinv * g0.w};
                ow[128 * j + 1] = (f32x4){f[4] * rinv * g1.x, f[5] * rinv * g1.y, f[6] * rinv * g1.z, f[7] * rinv * g1.w};
            }
        }
    }
#undef IN
#undef SEAM
}

extern "C" void kernel_launch(void* const* d_in, const int* in_sizes, int n_in, void* d_out, int out_size, void* d_ws, size_t ws_size, hipStream_t stream) {
    static int grid = 0;
    if (grid == 0) {
        if (n_in != 17 || in_sizes[0] != M * DM || out_size != M * DM || ws_size < WS_END) { fprintf(stderr, "kernel_launch: unexpected shapes (n_in %d, in0 %d, out %d, ws %zu); nothing launched\n", n_in, n_in > 0 ? in_sizes[0] : -1, out_size, ws_size); grid = -1; return; }
        int dev = 0, cus = 0, per_cu = 0;
        if (hipGetDevice(&dev) != hipSuccess || hipDeviceGetAttribute(&cus, hipDeviceAttributeMultiprocessorCount, dev) != hipSuccess) { grid = -1; return; }
        if (hipFuncSetAttribute((const void*)fwd_kernel, hipFuncAttributeMaxDynamicSharedMemorySize, LDS_BYTES) != hipSuccess) { fprintf(stderr, "kernel_launch: hipFuncSetAttribute failed\n"); grid = -1; return; }
        if (hipOccupancyMaxActiveBlocksPerMultiprocessor(&per_cu, (const void*)fwd_kernel, NWAVES * 64, LDS_BYTES) != hipSuccess || per_cu < 1) { fprintf(stderr, "kernel_launch: occupancy query says %d blocks per CU\n", per_cu); (void)hipGetLastError(); grid = -1; return; }
        grid = cus;
    }
    if (grid < 0) return;
    (void)hipMemsetAsync((char*)d_ws + WS_CTL, 0, CTL_ZERO_BYTES, stream);
    Args a{};
    const float** p = (const float**)&a;
    for (int i = 0; i < 17; ++i) p[i] = (const float*)d_in[i];
    a.out = (float*)d_out; a.ws = (unsigned char*)d_ws;
    for (int li = 0; li < N_LAUNCHES; ++li) {
        a.ph_lo = (N_LAUNCHES == 1) ? 0 : li; a.ph_hi = (N_LAUNCHES == 1) ? N_PHASES : li + 1;
        hipLaunchKernelGGL(fwd_kernel, dim3(grid), dim3(NWAVES * 64), LDS_BYTES, stream, a);
        const hipError_t le = hipPeekAtLastError();
        if (le != hipSuccess) { fprintf(stderr, "kernel_launch: launch %d failed: %s\n", li, hipGetErrorName(le)); break; }
    }
}
```

```cpp
#include <hip/hip_runtime.h>
#include <cstdio>
#include <cstdint>
namespace pg8 {
#define PG8_LAS __attribute__((address_space(3)))
typedef unsigned short bf16_t;
typedef short bf16x8 __attribute__((ext_vector_type(8)));
typedef float f32x4 __attribute__((ext_vector_type(4)));
typedef unsigned u32x4 __attribute__((ext_vector_type(4)));
constexpr int BM = 256, BK = 64, HALF = 128, HTB = HALF * BK * 2  , STAGE_BYTES = 8 * HTB, NXCD = 8, WGM = 8;

__host__ __device__ __forceinline__ int lds_byte(int r, int c) { const int st = (r >> 4) * 2 + (c >> 5), rr = r & 15, cc = c & 31, ob = rr * 64 + cc * 2; return st * 1024 + (ob ^ (((ob >> 9) & 1) << 5)); }
__host__ __device__ __forceinline__ void stage_rc(int b, int& R, int& C) { const int st = b / 1024, sb = b % 1024, swz = sb ^ (((sb >> 9) & 1) << 5); R = (st >> 1) * 16 + swz / 64; C = (st & 1) * 32 + (swz % 64) / 2; }
__host__ __device__ __forceinline__ int perm32(int rho) { const int n = rho >> 4, i = rho & 15; return 8 * (i >> 2) + 4 * n + (i & 3); }

struct Unit { int pm, pn; };
struct Gemm { const bf16_t* A; const bf16_t* Bt; int M, N, K; };

struct StaticOrder {
    int nM, nN, nwg, G, c;
    __host__ __device__ void init(int M, int N, int G_, int c_) { nM = M / BM; nN = N / BM; nwg = nM * nN; G = G_; c = c_; }
    __host__ __device__ bool next(int i, Unit& u) const {
        const long L = (long)i * G + c; if (L >= nwg) return false;
        int wgid = (int)L; { const int q = nwg / NXCD, r = nwg % NXCD, xcd = wgid % NXCD, off = wgid / NXCD; wgid = (xcd < r ? xcd * (q + 1) : r * (q + 1) + (xcd - r) * q) + off; }
        const int nig = WGM * nN, gid = wgid / nig, fm = gid * WGM, gsz = (nM - fm) < WGM ? (nM - fm) : WGM;
        u.pm = fm + ((wgid % nig) % gsz); u.pn = (wgid % nig) / gsz; return true;
    }
    __device__ __forceinline__ void a_ready(const Unit&) const {}
    __device__ __forceinline__ void done(const Unit&) const {}
};

__device__ __forceinline__ unsigned cvt_pk_bf16(float lo, float hi) { unsigned r; asm volatile("v_cvt_pk_bf16_f32 %0, %1, %2" : "=v"(r) : "v"(lo), "v"(hi)); return r; }
typedef float f32x2 __attribute__((ext_vector_type(2)));
typedef unsigned u32x2 __attribute__((ext_vector_type(2)));
__device__ __forceinline__ float gelu_t(float x) {
    const float t = x * (2.302208198f + 0.1029432397f * x * x);
    return x * __builtin_amdgcn_rcpf(1.0f + __builtin_amdgcn_exp2f(-t));
}
constexpr int E_DIN = 4352, E_DM = 2048, E_DFF = 8192;
constexpr float E_EPS = 1e-6f;
constexpr int PAN_MEMN = 64, PAN_WIN = 72, PAN_WKV = 89;

struct Order1 {
    StaticOrder so; int G, c, lo, hi;
    __device__ void init(int G_, int c_, int lo_, int hi_) { so.init(16384, E_DIN, 1, 0); G = G_; c = c_; lo = lo_; hi = hi_; }
    __device__ bool next(int i, Unit& u) const {
        const int L = lo + i * G + c;
        if (L >= hi) return false;
        if (L < 1088) { Unit t; so.next(L, t); u.pm = t.pm; u.pn = PAN_WIN + t.pn; return true; }
        const int r = L - 1088;
        if (r < 16) { u.pm = PAN_MEMN + (r & 7); u.pn = PAN_WKV + (r >> 3); return true; }
        if (r < 32) { const int q = r - 16; u.pm = PAN_WKV + 2 + (q >> 3); u.pn = PAN_MEMN + (q & 7); return true; }
        return false;
    }
    __device__ __forceinline__ void a_ready(const Unit&) const {}
    __device__ __forceinline__ void done(const Unit&) const {}
};

struct Epi1 {
    static constexpr bool PERM = true, AFTER_DRAIN = false;
    bf16_t* proj; bf16_t* kmat; bf16_t* vt; float* vstats; float qscale;
    __device__ __forceinline__ void operator()(const f32x4 (&acc)[2][2][4][2], const Unit& u, int wr, int wc, int fr, int fq) const {
        bf16_t* base; int ld, mode, rowt, colt, j = 0;
        const int pa = u.pm, pb = u.pn;
        if (pb >= PAN_WIN && pb < PAN_WKV) { j = pb - PAN_WIN; base = proj; ld = E_DIN; rowt = pa * 256; colt = j * 256; mode = j < 3 ? 1 : (j < 6 ? 2 : (j >= 15 ? 3 : 0)); }
        else if (pb >= PAN_WKV) { base = kmat; ld = 512; rowt = (pa - PAN_MEMN) * 256; colt = (pb - PAN_WKV) * 256; mode = 0; }
        else { base = vt; ld = 2048; rowt = (pa - PAN_WKV - 2) * 256; colt = (pb - PAN_MEMN) * 256; mode = 0; }
        const int row0 = rowt + wr * 64 + fr, col0 = colt + wc * 32 + 8 * fq;
        const float sc = mode == 3 ? qscale : 1.0f;
#pragma unroll
        for (int ai = 0; ai < 2; ++ai)
#pragma unroll
            for (int m = 0; m < 4; ++m) {
                const int row = row0 + ai * HALF + m * 16;
                bf16_t* rowp = base + (size_t)row * ld + col0;
                float s1 = 0.f, s2 = 0.f;
#pragma unroll
                for (int bj = 0; bj < 2; ++bj) {
                    f32x4 v0 = acc[ai][bj][m][0], v1 = acc[ai][bj][m][1];
                    if (mode == 1 || mode == 2) {
#pragma unroll
                        for (int e = 0; e < 4; ++e) { v0[e] = gelu_t(v0[e]); v1[e] = gelu_t(v1[e]); }
                        if (mode == 2) {
#pragma unroll
                            for (int e = 0; e < 4; ++e) { s1 += v0[e] + v1[e]; s2 += v0[e] * v0[e] + v1[e] * v1[e]; }
                        }
                    } else { v0 = v0 * sc; v1 = v1 * sc; }
                    u32x4 w; w.x = cvt_pk_bf16(v0[0], v0[1]); w.y = cvt_pk_bf16(v0[2], v0[3]); w.z = cvt_pk_bf16(v1[0], v1[1]); w.w = cvt_pk_bf16(v1[2], v1[3]);
                    *(u32x4*)(rowp + bj * HALF) = w;
                }
                if (mode == 2) {
                    s1 += __shfl_xor(s1, 16); s1 += __shfl_xor(s1, 32); s2 += __shfl_xor(s2, 16); s2 += __shfl_xor(s2, 32);
                    if (fq == 0) *(f32x2*)(vstats + ((size_t)row * 12 + (j - 3) * 4 + wc) * 2) = (f32x2){s1, s2};
                }
            }
    }
};
struct Epi3 {
    static constexpr bool PERM = true, AFTER_DRAIN = false;
    const float* x; bf16_t* x1b; float* ssq;
    __device__ __forceinline__ void operator()(const f32x4 (&acc)[2][2][4][2], const Unit& u, int wr, int wc, int fr, int fq) const {
        const int row0 = u.pm * BM + wr * 64 + fr, col0 = u.pn * BM + wc * 32 + 8 * fq;
#pragma unroll
        for (int ai = 0; ai < 2; ++ai)
#pragma unroll
            for (int m = 0; m < 4; ++m) {
                const int row = row0 + ai * HALF + m * 16; const size_t off = (size_t)row * E_DM + col0; float s = 0.f;
#pragma unroll
                for (int bj = 0; bj < 2; ++bj) {
                    const f32x4 o0 = *(const f32x4*)(x + off + bj * HALF) + acc[ai][bj][m][0], o1 = *(const f32x4*)(x + off + bj * HALF + 4) + acc[ai][bj][m][1];
                    s += ((o0[0] * o0[0] + o0[1] * o0[1]) + (o0[2] * o0[2] + o0[3] * o0[3])) + ((o1[0] * o1[0] + o1[1] * o1[1]) + (o1[2] * o1[2] + o1[3] * o1[3]));
                    u32x4 w; w.x = cvt_pk_bf16(o0[0], o0[1]); w.y = cvt_pk_bf16(o0[2], o0[3]); w.z = cvt_pk_bf16(o1[0], o1[1]); w.w = cvt_pk_bf16(o1[2], o1[3]);
                    *(u32x4*)(x1b + off + bj * HALF) = w;
                }
                s += __shfl_xor(s, 16); s += __shfl_xor(s, 32);
                if (fq == 0) ssq[(size_t)row * 32 + u.pn * 4 + wc] = s;
            }
    }
};
struct Epi4 {
    static constexpr bool PERM = true, AFTER_DRAIN = false;
    bf16_t* hid; const float* ssq;
    __device__ __forceinline__ void operator()(const f32x4 (&acc)[2][2][4][2], const Unit& u, int wr, int wc, int fr, int fq) const {
        const int row0 = u.pm * BM + wr * 64 + fr, col0 = u.pn * BM + wc * 32 + 8 * fq;
#pragma unroll
        for (int ai = 0; ai < 2; ++ai)
#pragma unroll
            for (int m = 0; m < 4; ++m) {
                const int row = row0 + ai * HALF + m * 16;
                const f32x4 p0 = *(const f32x4*)(ssq + (size_t)row * 32 + 8 * fq), p1 = *(const f32x4*)(ssq + (size_t)row * 32 + 8 * fq + 4);
                float s = ((p0[0] + p0[1]) + (p0[2] + p0[3])) + ((p1[0] + p1[1]) + (p1[2] + p1[3]));
                s += __shfl_xor(s, 16); s += __shfl_xor(s, 32);
                const float rinv = __builtin_amdgcn_rsqf(s * (1.0f / E_DM) + E_EPS);
                bf16_t* rowp = hid + (size_t)row * E_DFF + col0;
#pragma unroll
                for (int bj = 0; bj < 2; ++bj) {
                    f32x4 v0 = acc[ai][bj][m][0] * rinv, v1 = acc[ai][bj][m][1] * rinv;
#pragma unroll
                    for (int e = 0; e < 4; ++e) { const float a = fmaxf(v0[e], 0.f), b = fmaxf(v1[e], 0.f); v0[e] = a * a; v1[e] = b * b; }
                    u32x4 w; w.x = cvt_pk_bf16(v0[0], v0[1]); w.y = cvt_pk_bf16(v0[2], v0[3]); w.z = cvt_pk_bf16(v1[0], v1[1]); w.w = cvt_pk_bf16(v1[2], v1[3]);
                    *(u32x4*)(rowp + bj * HALF) = w;
                }
            }
    }
};
__device__ __forceinline__ float bf_lo(unsigned u) { return __builtin_bit_cast(float, u << 16); }
__device__ __forceinline__ float bf_hi(unsigned u) { return __builtin_bit_cast(float, u & 0xffff0000u); }
struct Epi5 {
    static constexpr bool PERM = true, AFTER_DRAIN = false;
    bf16_t* x1b; float* ssq;
    __device__ __forceinline__ void operator()(const f32x4 (&acc)[2][2][4][2], const Unit& u, int wr, int wc, int fr, int fq) const {
        const int row0 = u.pm * BM + wr * 64 + fr, col0 = u.pn * BM + wc * 32 + 8 * fq;
#pragma unroll
        for (int ai = 0; ai < 2; ++ai)
#pragma unroll
            for (int m = 0; m < 4; ++m) {
                const int row = row0 + ai * HALF + m * 16; const size_t off = (size_t)row * E_DM + col0; float s = 0.f;
#pragma unroll
                for (int bj = 0; bj < 2; ++bj) {
                    const u32x4 xi = *(const u32x4*)(x1b + off + bj * HALF);
                    const f32x4 o0 = (f32x4){bf_lo(xi.x), bf_hi(xi.x), bf_lo(xi.y), bf_hi(xi.y)} + acc[ai][bj][m][0], o1 = (f32x4){bf_lo(xi.z), bf_hi(xi.z), bf_lo(xi.w), bf_hi(xi.w)} + acc[ai][bj][m][1];
                    s += ((o0[0] * o0[0] + o0[1] * o0[1]) + (o0[2] * o0[2] + o0[3] * o0[3])) + ((o1[0] * o1[0] + o1[1] * o1[1]) + (o1[2] * o1[2] + o1[3] * o1[3]));
                    u32x4 w; w.x = cvt_pk_bf16(o0[0], o0[1]); w.y = cvt_pk_bf16(o0[2], o0[3]); w.z = cvt_pk_bf16(o1[0], o1[1]); w.w = cvt_pk_bf16(o1[2], o1[3]);
                    *(u32x4*)(x1b + off + bj * HALF) = w;
                }
                s += __shfl_xor(s, 16); s += __shfl_xor(s, 32);
                if (fq == 0) ssq[(size_t)row * 32 + u.pn * 4 + wc] = s;
            }
    }
};

template <class Epi, class Sched, bool ALIGN_EPI = false, bool SP2 = false>
__device__ __forceinline__ void gemm_phase(PG8_LAS unsigned char* lds, const Gemm g, const Sched& S, const Epi& E) {
    const int tid = threadIdx.x, wid = __builtin_amdgcn_readfirstlane(tid >> 6), lane = tid & 63, wr = wid >> 2, wc = wid & 3, fr = lane & 15, fq = lane >> 4;
    const int K = g.K, nt = K / BK;
    unsigned voffA[2], voffB[2];
#pragma unroll
    for (int i = 0; i < 2; ++i) { int R, C; stage_rc(tid * 16 + i * 8192, R, C); const int Rb = Epi::PERM ? ((R & ~31) + perm32(R & 31)) : R;
        voffA[i] = (unsigned)(R * K + C) * 2u; voffB[i] = (unsigned)(Rb * K + C) * 2u; }
    const size_t kstep = (size_t)(BK * 2);
    const size_t hstep = (size_t)HALF * K * 2;
    const size_t tstep = 2 * hstep;
    const unsigned ldsw = (unsigned)wid * 1024u;
    const int aoff = lds_byte(wr * 64 + fr, fq * 8), boff = lds_byte(wc * 32 + fr, fq * 8);
#define PG8_SA(b, h) (((b) * 2 + (h)) * HTB)
#define PG8_SB(b, h) ((4 + (b) * 2 + (h)) * HTB)
#define PG8_STAGE(bufoff, gbase, voff) do { _Pragma("unroll") for (int _i = 0; _i < 2; ++_i) \
        __builtin_amdgcn_global_load_lds((const unsigned*)((const char*)(gbase) + (voff)[_i]), (PG8_LAS unsigned*)(lds + (bufoff) + ldsw + _i * 8192), 16, 0, 0); } while (0)
#define PG8_LDA(dst, b, h) do { _Pragma("unroll") for (int m = 0; m < 4; ++m) _Pragma("unroll") for (int k = 0; k < 2; ++k) dst[m][k] = *(const PG8_LAS bf16x8*)(lds + PG8_SA(b, h) + aoff + m * 2048 + k * 1024); } while (0)
#define PG8_LDB(dst, b, h) do { _Pragma("unroll") for (int n = 0; n < 2; ++n) _Pragma("unroll") for (int k = 0; k < 2; ++k) dst[n][k] = *(const PG8_LAS bf16x8*)(lds + PG8_SB(b, h) + boff + n * 2048 + k * 1024); } while (0)
#define PG8_MMA(ai, bj, At, Bt) do { __builtin_amdgcn_s_setprio(1); _Pragma("unroll") for (int m = 0; m < 4; ++m) _Pragma("unroll") for (int n = 0; n < 2; ++n) _Pragma("unroll") for (int k = 0; k < 2; ++k) \
        acc[ai][bj][m][n] = __builtin_amdgcn_mfma_f32_16x16x32_bf16(Bt[n][k], At[m][k], acc[ai][bj][m][n], 0, 0, 0); __builtin_amdgcn_s_setprio(0); } while (0)
#define PG8_WAIT_V(n) asm volatile("s_waitcnt vmcnt(" #n ")" ::: "memory")
#define PG8_WAIT_L(n) asm volatile("s_waitcnt lgkmcnt(" #n ")" ::: "memory")
#define PG8_BAR __builtin_amdgcn_s_barrier()
#define PG8_SCHED __builtin_amdgcn_sched_barrier(0)
    Unit cur, nxt; int ui = 0;
    if (!S.next(0, cur)) return;
    f32x4 acc[2][2][4][2];
#pragma unroll
    for (int a = 0; a < 2; ++a)
#pragma unroll
        for (int b = 0; b < 2; ++b)
#pragma unroll
            for (int m = 0; m < 4; ++m)
#pragma unroll
                for (int n = 0; n < 2; ++n) acc[a][b][m][n] = (f32x4){0.f, 0.f, 0.f, 0.f};
    bf16x8 At[4][2], B0[2][2], B1[2][2];
    const char* cA = (const char*)g.A + (size_t)cur.pm * tstep; const char* cB = (const char*)g.Bt + (size_t)cur.pn * tstep;
    S.a_ready(cur);
    if constexpr (SP2) {
        PG8_STAGE(PG8_SB(0, 0), cB, voffB); PG8_STAGE(PG8_SB(0, 1), cB + hstep, voffB); PG8_STAGE(PG8_SA(0, 0), cA, voffA); PG8_STAGE(PG8_SA(0, 1), cA + hstep, voffA);
        if (wr == 1) PG8_BAR;
        PG8_WAIT_V(2); PG8_BAR;
        PG8_STAGE(PG8_SB(1, 0), cB + kstep, voffB); PG8_STAGE(PG8_SA(1, 0), cA + kstep, voffA); PG8_STAGE(PG8_SB(1, 1), cB + hstep + kstep, voffB);
        PG8_WAIT_V(6); PG8_BAR;
    } else {
        PG8_STAGE(PG8_SB(0, 0), cB, voffB); PG8_STAGE(PG8_SA(0, 0), cA, voffA); PG8_STAGE(PG8_SB(0, 1), cB + hstep, voffB); PG8_STAGE(PG8_SA(0, 1), cA + hstep, voffA);
        if (wr == 1) PG8_BAR;
        PG8_WAIT_V(4); PG8_BAR;
        PG8_STAGE(PG8_SB(1, 0), cB + kstep, voffB); PG8_STAGE(PG8_SA(1, 0), cA + kstep, voffA); PG8_STAGE(PG8_SB(1, 1), cB + hstep + kstep, voffB);
        PG8_WAIT_V(6); PG8_BAR;
    }
    for (;;) {
        const bool has_next = S.next(ui + 1, nxt);
        const char* nA = has_next ? (const char*)g.A + (size_t)nxt.pm * tstep : cA; const char* nB = has_next ? (const char*)g.Bt + (size_t)nxt.pn * tstep : cB;
        for (int t = 0; t < nt; t += 2) {
            const bool last = (t == nt - 2);
            const char* a1 = cA + (size_t)(t + 1) * kstep;
            const char* a2 = last ? nA : cA + (size_t)(t + 2) * kstep; const char* b2 = last ? nB : cB + (size_t)(t + 2) * kstep;
            const char* a3 = a2 + kstep; const char* b3 = b2 + kstep;
            if (last && has_next) S.a_ready(nxt);
            if constexpr (SP2) {
            PG8_LDB(B0, 0, 0); PG8_LDB(B1, 0, 1); PG8_SCHED; PG8_LDA(At, 0, 0); PG8_STAGE(PG8_SA(1, 1), a1 + hstep, voffA);
            PG8_WAIT_V(8); PG8_WAIT_L(0); PG8_BAR; PG8_MMA(0, 0, At, B0); PG8_MMA(0, 1, At, B1); PG8_BAR; PG8_SCHED;
            PG8_LDA(At, 0, 1); PG8_STAGE(PG8_SB(0, 0), b2, voffB); PG8_STAGE(PG8_SB(0, 1), b2 + hstep, voffB); PG8_STAGE(PG8_SA(0, 0), a2, voffA);
            PG8_WAIT_V(8); PG8_WAIT_L(0); PG8_BAR; PG8_MMA(1, 0, At, B0); PG8_MMA(1, 1, At, B1); PG8_BAR; PG8_SCHED;
            PG8_LDB(B0, 1, 0); PG8_LDB(B1, 1, 1); PG8_SCHED; PG8_LDA(At, 1, 0); PG8_STAGE(PG8_SA(0, 1), a2 + hstep, voffA);
            PG8_WAIT_V(8); PG8_WAIT_L(0); PG8_BAR; PG8_MMA(0, 0, At, B0); PG8_MMA(0, 1, At, B1); PG8_BAR; PG8_SCHED;
            PG8_LDA(At, 1, 1); PG8_STAGE(PG8_SB(1, 0), b3, voffB); PG8_STAGE(PG8_SB(1, 1), b3 + hstep, voffB); PG8_STAGE(PG8_SA(1, 0), a3, voffA);
            PG8_WAIT_V(8); PG8_WAIT_L(0); PG8_BAR; PG8_MMA(1, 0, At, B0); PG8_MMA(1, 1, At, B1); PG8_BAR; PG8_SCHED;
            } else {
            PG8_LDB(B0, 0, 0); PG8_SCHED; PG8_LDA(At, 0, 0); PG8_STAGE(PG8_SA(1, 1), a1 + hstep, voffA);
            PG8_WAIT_L(8); PG8_BAR; PG8_WAIT_L(0); PG8_MMA(0, 0, At, B0); PG8_BAR; PG8_SCHED;
            PG8_LDB(B1, 0, 1); PG8_STAGE(PG8_SB(0, 0), b2, voffB);
            PG8_BAR; PG8_WAIT_L(0); PG8_MMA(0, 1, At, B1); PG8_BAR;
            PG8_LDA(At, 0, 1); PG8_STAGE(PG8_SA(0, 0), a2, voffA);
            PG8_BAR; PG8_WAIT_L(0); PG8_MMA(1, 0, At, B0); PG8_BAR; PG8_SCHED;
            PG8_STAGE(PG8_SB(0, 1), b2 + hstep, voffB);
            PG8_WAIT_V(6); PG8_BAR; PG8_MMA(1, 1, At, B1); PG8_BAR;
            PG8_LDB(B0, 1, 0); PG8_SCHED; PG8_LDA(At, 1, 0); PG8_STAGE(PG8_SA(0, 1), a2 + hstep, voffA);
            PG8_WAIT_L(8); PG8_BAR; PG8_WAIT_L(0); PG8_MMA(0, 0, At, B0); PG8_BAR; PG8_SCHED;
            PG8_LDB(B1, 1, 1); PG8_STAGE(PG8_SB(1, 0), b3, voffB);
            PG8_BAR; PG8_WAIT_L(0); PG8_MMA(0, 1, At, B1); PG8_BAR;
            PG8_LDA(At, 1, 1); PG8_STAGE(PG8_SA(1, 0), a3, voffA);
            PG8_BAR; PG8_WAIT_L(0); PG8_MMA(1, 0, At, B0); PG8_BAR; PG8_SCHED;
            PG8_STAGE(PG8_SB(1, 1), b3 + hstep, voffB);
            PG8_WAIT_V(6); PG8_BAR; PG8_MMA(1, 1, At, B1); PG8_BAR;
            }
        }
        if constexpr (ALIGN_EPI) { if (wr == 0) PG8_BAR; }
        if constexpr (!Epi::AFTER_DRAIN) { E(acc, cur, wr, wc, fr, fq); S.done(cur); }
        if (!has_next) break;
#pragma unroll
        for (int a = 0; a < 2; ++a)
#pragma unroll
            for (int b = 0; b < 2; ++b)
#pragma unroll
                for (int m = 0; m < 4; ++m)
#pragma unroll
                    for (int n = 0; n < 2; ++n) acc[a][b][m][n] = (f32x4){0.f, 0.f, 0.f, 0.f};
        cur = nxt; cA = nA; cB = nB; ++ui;
        if constexpr (ALIGN_EPI) { if (wr == 1) PG8_BAR; }
    }
    PG8_WAIT_V(0);
    if constexpr (!ALIGN_EPI) { if (wr == 0) PG8_BAR; }
    PG8_BAR;
    if constexpr (Epi::AFTER_DRAIN) { E.fused(acc, cur, wr, wc, fr, fq, lds, wid, lane); S.done(cur); }
#undef PG8_SA
#undef PG8_SB
#undef PG8_STAGE
#undef PG8_LDA
#undef PG8_LDB
#undef PG8_MMA
#undef PG8_WAIT_V
#undef PG8_WAIT_L
#undef PG8_BAR
#undef PG8_SCHED
}
}

constexpr int NWAVES = 8;
constexpr int NB = 8, SEQ = 2048, DM = 2048, M = NB * SEQ;
constexpr int DSGU = 768, DCONV = 768, DMEM = 512, DIN = 4352, DFF = 8192, NMEM = 256, HD = 128, CHUNK = 128;
constexpr int OFF_U = 0, OFF_V = 768, OFF_B = 1536, OFF_C = 2304, OFF_X = 3072, OFF_Q = 3840;
constexpr float EPS = 1e-6f;
constexpr float QSCALE = 0.08838834764831845f * 1.4426950408889634f;
#ifndef MK_N_LAUNCHES
#define MK_N_LAUNCHES 1
#endif
constexpr int N_PHASES = 8;
constexpr int N_LAUNCHES = MK_N_LAUNCHES;

constexpr size_t MiB = 1u << 20;
constexpr size_t WS_CTL = 0, CTL_ZERO_BYTES = 64 * 1024;
constexpr size_t WS_VSTATS = 1 * MiB;
constexpr size_t WS_SSQ1 = 3 * MiB;
constexpr size_t WS_SSQ2 = 5 * MiB;
constexpr size_t WS_WO = 8 * MiB;
constexpr size_t WS_W1 = 16 * MiB;
constexpr size_t WS_W2 = 48 * MiB;
constexpr size_t WS_KMAT = 80 * MiB;
constexpr size_t WS_VT = 82 * MiB;
constexpr size_t WS_BIG = 84 * MiB;
constexpr size_t WS_XN = WS_BIG, WS_MEMN = WS_BIG + 64 * MiB, WS_WIN = WS_BIG + 72 * MiB, WS_WKV = WS_BIG + 89 * MiB;
constexpr size_t WS_X1B = WS_XN;
constexpr size_t WS_PROJ = 180 * MiB;
constexpr size_t WS_HEADS = 316 * MiB;
constexpr size_t WS_HID = 180 * MiB;
constexpr size_t WS_END = 436 * MiB;
constexpr int CW_BAR = 1024;
constexpr int CW_QUEUE = 64;

constexpr int SCRATCH_BYTES = 139264;
constexpr int MISC_OFF = SCRATCH_BYTES;
constexpr int LDS_BYTES = 147456;

#define GAS __attribute__((address_space(1)))
#define LAS __attribute__((address_space(3)))
typedef unsigned short bf16;
typedef unsigned v4u __attribute__((ext_vector_type(4)));
typedef float f32x4 __attribute__((ext_vector_type(4)));
typedef short bf16x8 __attribute__((ext_vector_type(8)));
typedef GAS unsigned gu32;
typedef GAS unsigned long long gu64;
#define RLX_AGENT __ATOMIC_RELAXED, __HIP_MEMORY_SCOPE_AGENT
#define LDS_WAIT() asm volatile("s_waitcnt lgkmcnt(0)" ::: "memory")
#define VM_WAIT() asm volatile("s_waitcnt vmcnt(0)" ::: "memory")
__device__ __forceinline__ unsigned long long rt() { return __builtin_amdgcn_s_memrealtime(); }
__device__ __forceinline__ unsigned f2bf(float f) { unsigned u = __builtin_bit_cast(unsigned, f); return (u + 0x7fffu + ((u >> 16) & 1u)) >> 16; }
__device__ __forceinline__ unsigned pk2(float lo, float hi) { return f2bf(lo) | (f2bf(hi) << 16); }

#define XB_TMO      128
#define XB_XCNT(j)  (256  + 64 * (j))
#define XB_XSUB(j)  (1280 + 64 * (j))
#define XB_XGEN(j)  (2304 + 64 * (j))
#define XB_TOP      3328
#define XB_TOPGEN   3392
#define XCD_BAR_WORDS 3456
#define XB_SPIN_CAP (1u << 18)

__device__ __forceinline__ unsigned xb_ld(unsigned* p)              { return __hip_atomic_load(p, __ATOMIC_RELAXED, __HIP_MEMORY_SCOPE_AGENT); }
__device__ __forceinline__ unsigned xb_add(unsigned* p, unsigned v) { return __hip_atomic_fetch_add(p, v, __ATOMIC_RELAXED, __HIP_MEMORY_SCOPE_AGENT); }
__device__ __forceinline__ unsigned xb_xcc_id() { return (unsigned)__builtin_amdgcn_s_getreg((3 << 11) | 20) & 0xFu; }
#define XB_SPIN(cond, bar) do { unsigned _sp = 0; while (cond) { __builtin_amdgcn_s_sleep(1); \
    if ((++_sp & 255u) == 0u) { if (xb_ld(&(bar)[XB_TMO])) break; if (_sp > XB_SPIN_CAP) { atomicAdd(&(bar)[XB_TMO], 1u); break; } } } } while (0)

struct XcdBarrier {
    unsigned* bar; unsigned x;
    volatile LAS unsigned* st;
};

__device__ __forceinline__ XcdBarrier xcd_barrier_post(unsigned* bar, volatile LAS unsigned* st) {
    XcdBarrier b; b.bar = bar; b.x = xb_xcc_id(); b.st = st;
    if (threadIdx.x == 0) (void)xb_add(&bar[XB_XCNT(b.x)], 1u);
    return b;
}
__device__ __forceinline__ void xcd_barrier_complete(unsigned* bar, unsigned x, unsigned& nloc, unsigned& nx) {
    const unsigned G = gridDim.x * gridDim.y * gridDim.z;
    unsigned sum, cnt, mine, sp = 0u;
    for (;;) {
        sum = 0u; cnt = 0u; mine = 0u;
#pragma unroll
        for (unsigned j = 0; j < 16; ++j) { const unsigned c = xb_ld(&bar[XB_XCNT(j)]); sum += c; cnt += (c > 0u) ? 1u : 0u; mine = (j == x) ? c : mine; }
        if (sum == G) break;
        __builtin_amdgcn_s_sleep(1);
        if ((++sp & 255u) == 0u) { if (xb_ld(&bar[XB_TMO])) break; if (sp > XB_SPIN_CAP) { atomicAdd(&bar[XB_TMO], 1u); break; } }
    }
    nloc = mine > 0u ? mine : 1u; nx = cnt > 0u ? cnt : 1u;
}

__device__ __forceinline__ void xcd_barrier(const XcdBarrier& b) {
    asm volatile("s_waitcnt vmcnt(0)" ::: "memory");
    __syncthreads();
    if (threadIdx.x == 0) {
        unsigned* bar = b.bar;
        __builtin_amdgcn_s_waitcnt(0);
        unsigned nloc = b.st[0], nx = b.st[1];
        if (nloc == 0u) { xcd_barrier_complete(bar, b.x, nloc, nx); b.st[0] = nloc; b.st[1] = nx; }
        const unsigned old = xb_add(&bar[XB_XSUB(b.x)], 1u);
        const unsigned gen = old / nloc;
        if (old + 1u == (gen + 1u) * nloc) {
            __builtin_amdgcn_fence(__ATOMIC_RELEASE, "agent");
            asm volatile("s_waitcnt vmcnt(0)" ::: "memory");
            const unsigned og = xb_add(&bar[XB_TOP], 1u);
            const unsigned tg = og / nx;
            if (og + 1u == (tg + 1u) * nx) xb_add(&bar[XB_TOPGEN], 1u);
            else XB_SPIN(xb_ld(&bar[XB_TOPGEN]) == tg, bar);
            __builtin_amdgcn_fence(__ATOMIC_ACQUIRE, "agent");
            xb_add(&bar[XB_XGEN(b.x)], 1u);
            asm volatile("s_waitcnt vmcnt(0)" ::: "memory");
        } else {
            XB_SPIN(xb_ld(&bar[XB_XGEN(b.x)]) == gen, bar);
            __builtin_amdgcn_fence(__ATOMIC_ACQUIRE, "agent");
            asm volatile("s_waitcnt vmcnt(0)" ::: "memory");
        }
    }
    __syncthreads();
}

typedef unsigned v2u __attribute__((ext_vector_type(2)));
typedef float f32x2 __attribute__((ext_vector_type(2)));
typedef short bf16x4 __attribute__((ext_vector_type(4)));
__device__ __forceinline__ float bflo(unsigned u) { return __builtin_bit_cast(float, u << 16); }
__device__ __forceinline__ float bfhi(unsigned u) { return __builtin_bit_cast(float, u & 0xffff0000u); }
__device__ __forceinline__ void unpack8(const v4u w, float (&f)[8]) { f[0] = bflo(w.x); f[1] = bfhi(w.x); f[2] = bflo(w.y); f[3] = bfhi(w.y); f[4] = bflo(w.z); f[5] = bfhi(w.z); f[6] = bflo(w.w); f[7] = bfhi(w.w); }


struct Args {
    const float *x, *mem, *g_mix, *w_in, *ln_g, *ln_b, *w_s, *b_s, *conv_w, *g_mem, *w_kv, *g_head, *w_o, *g_ffn, *w1, *w2, *g_final;
    float* out; unsigned char* ws; int ph_lo, ph_hi;
};

__device__ __forceinline__ float wave_sum(float v) {
#pragma unroll
    for (int o = 1; o < 64; o <<= 1) v += __shfl_xor(v, o);
    return v;
}
__device__ __forceinline__ void p0_transpose_item(const float* W, int K, int N, bf16* WT, const float* ks, LAS unsigned* scr, int item, int lane) {
    const int nblk = N / 64, kb = item / nblk, nb = item % nblk, k0 = 64 * kb, n0 = 64 * nb;
    const int n4 = (lane & 15) * 4, kr2 = lane >> 4;
    f32x4 a[8], b[8];
#pragma unroll
    for (int i = 0; i < 8; ++i) { const float* p = W + (size_t)(k0 + 8 * i + 2 * kr2) * N + n0 + n4; a[i] = *(const GAS f32x4*)p; b[i] = *(const GAS f32x4*)(p + N); }
    if (ks) {
#pragma unroll
        for (int i = 0; i < 8; ++i) { const float s0 = ks[k0 + 8 * i + 2 * kr2], s1 = ks[k0 + 8 * i + 2 * kr2 + 1]; a[i] = a[i] * s0; b[i] = b[i] * s1; }
    }
#pragma unroll
    for (int i = 0; i < 8; ++i) { LAS unsigned* d = scr + n4 * 33 + 4 * i + kr2;
        d[0] = pg8::cvt_pk_bf16(a[i].x, b[i].x); d[33] = pg8::cvt_pk_bf16(a[i].y, b[i].y); d[66] = pg8::cvt_pk_bf16(a[i].z, b[i].z); d[99] = pg8::cvt_pk_bf16(a[i].w, b[i].w); }
    LDS_WAIT(); asm volatile("" ::: "memory");
    const int c = lane & 7;
#pragma unroll
    for (int j = 0; j < 8; ++j) { const int n = (lane >> 3) + 8 * j; const LAS unsigned* sp = scr + n * 33 + 4 * c;
        v4u o; o.x = sp[0]; o.y = sp[1]; o.z = sp[2]; o.w = sp[3];
        *(GAS v4u*)(WT + (size_t)(n0 + n) * K + k0 + 8 * c) = o; }
    LDS_WAIT(); asm volatile("" ::: "memory");
}
__device__ __forceinline__ void rms_row_to_bf16(const float* xrow, const float* gain, bf16* orow, int lane) {
    const GAS f32x4* xr = (const GAS f32x4*)xrow + lane; const GAS f32x4* gr = (const GAS f32x4*)gain + lane;
    f32x4 v[8]; float s = 0.f;
#pragma unroll
    for (int j = 0; j < 8; ++j) { v[j] = xr[64 * j]; s += (v[j].x * v[j].x + v[j].y * v[j].y) + (v[j].z * v[j].z + v[j].w * v[j].w); }
    const float rinv = 1.0f / sqrtf(wave_sum(s) * (1.f / DM) + EPS);
    GAS v2u* o8 = (GAS v2u*)orow + lane;
#pragma unroll
    for (int j = 0; j < 8; ++j) { const f32x4 g = gr[64 * j]; v2u o; o.x = pg8::cvt_pk_bf16(v[j].x * rinv * g.x, v[j].y * rinv * g.y); o.y = pg8::cvt_pk_bf16(v[j].z * rinv * g.z, v[j].w * rinv * g.w); o8[64 * j] = o; }
}

__device__ __forceinline__ void head_norm_store(float (&v)[4][8], size_t row, int hcol0, int g, const float* g_head, bf16* heads) {
    float s = 0.f;
#pragma unroll
    for (int p = 0; p < 4; ++p)
#pragma unroll
        for (int e = 0; e < 8; ++e) s += v[p][e] * v[p][e];
    s += __shfl_xor(s, 16); s += __shfl_xor(s, 32);
    const float rinv = 1.0f / sqrtf(s * (1.f / HD) + EPS);
#pragma unroll
    for (int p = 0; p < 4; ++p) {
        const int c = hcol0 + 32 * p + 8 * g;
        const f32x4 g0 = *(const GAS f32x4*)(g_head + c), g1 = *(const GAS f32x4*)(g_head + c + 4);
        v4u w; w.x = pg8::cvt_pk_bf16(v[p][0] * rinv * g0.x, v[p][1] * rinv * g0.y); w.y = pg8::cvt_pk_bf16(v[p][2] * rinv * g0.z, v[p][3] * rinv * g0.w);
        w.z = pg8::cvt_pk_bf16(v[p][4] * rinv * g1.x, v[p][5] * rinv * g1.y); w.w = pg8::cvt_pk_bf16(v[p][6] * rinv * g1.z, v[p][7] * rinv * g1.w);
        *(GAS v4u*)(heads + row * DM + c) = w;
    }
}

constexpr int VROW = 272;
constexpr int KROW = 272;
constexpr int VTROW = 528;
constexpr int K_BYTES = 256 * KROW;
static_assert(K_BYTES + 128 * VTROW <= SCRATCH_BYTES, "attention tiles fit the scratch");

__device__ __forceinline__ void sgu_unit(const Args& A, LAS unsigned char* lds, int R0, int h, int tid) {
    const bf16* proj = (const bf16*)(A.ws + WS_PROJ); const float* vstats = (const float*)(A.ws + WS_VSTATS); bf16* heads = (bf16*)(A.ws + WS_HEADS);
    const int lane = tid & 63, w = __builtin_amdgcn_readfirstlane(tid >> 6), fr = lane & 15, g = lane >> 4;
    const int t = 16 * w + fr;
    const int nks = (w >> 1) + 1;
    const int sp = tid >> 3, dc = tid & 7, d0 = 16 * dc;
    f32x4 stv[2][6]; v4u gvv[2][2];
#pragma unroll
    for (int r = 0; r < 2; ++r) {
        const GAS f32x4* st = (const GAS f32x4*)(vstats + (size_t)(R0 + 2 * sp + r) * 24);
#pragma unroll
        for (int i = 0; i < 6; ++i) stv[r][i] = st[i];
        const GAS v4u* src = (const GAS v4u*)(proj + (size_t)(R0 + 2 * sp + r) * DIN + OFF_V + h * HD + d0);
        gvv[r][0] = src[0]; gvv[r][1] = src[1];
    }
    const float* wrow = A.w_s + ((size_t)h * CHUNK + t) * CHUNK;
    f32x4 wv[4][2];
#pragma unroll
    for (int ks = 0; ks < 4; ++ks) if (ks < nks) { wv[ks][0] = *(const GAS f32x4*)(wrow + 32 * ks + 8 * g); wv[ks][1] = *(const GAS f32x4*)(wrow + 32 * ks + 8 * g + 4); }
    v4u guv[4];
#pragma unroll
    for (int p = 0; p < 4; ++p) guv[p] = *(const GAS v4u*)(proj + (size_t)(R0 + t) * DIN + OFF_U + h * HD + 32 * p + 8 * g);
    const float bias = A.b_s[h * CHUNK + t];
    {
        float mean[2], rstd[2];
#pragma unroll
        for (int r = 0; r < 2; ++r) {
            float s1 = 0.f, s2 = 0.f;
#pragma unroll
            for (int i = 0; i < 6; ++i) { const f32x4 tt = stv[r][i]; s1 += tt.x + tt.z; s2 += tt.y + tt.w; }
            mean[r] = s1 * (1.f / DSGU); const float var = s2 * (1.f / DSGU) - mean[r] * mean[r]; rstd[r] = 1.0f / sqrtf(fmaxf(var, 0.f) + EPS);
        }
        float val[2][16];
#pragma unroll
        for (int r = 0; r < 2; ++r) {
            float f0[8], f1[8]; unpack8(gvv[r][0], f0); unpack8(gvv[r][1], f1);
#pragma unroll
            for (int e = 0; e < 8; ++e) { val[r][e] = (f0[e] - mean[r]) * rstd[r]; val[r][8 + e] = (f1[e] - mean[r]) * rstd[r]; }
        }
#pragma unroll
        for (int q = 0; q < 4; ++q) {
            const f32x4 lg = *(const GAS f32x4*)(A.ln_g + h * HD + d0 + 4 * q), lb = *(const GAS f32x4*)(A.ln_b + h * HD + d0 + 4 * q);
#pragma unroll
            for (int e = 0; e < 4; ++e) {
                const int i = 4 * q + e;
                *(LAS unsigned*)(lds + (d0 + i) * VROW + 4 * sp) = pg8::cvt_pk_bf16(val[0][i] * lg[e] + lb[e], val[1][i] * lg[e] + lb[e]);
            }
        }
    }
    __syncthreads();
    f32x4 acc[4][2];
#pragma unroll
    for (int p = 0; p < 4; ++p)
#pragma unroll
        for (int q = 0; q < 2; ++q) acc[p][q] = (f32x4){0.f, 0.f, 0.f, 0.f};
#pragma unroll
    for (int ks = 0; ks < 4; ++ks) if (ks < nks) {
        const int s0 = 32 * ks + 8 * g;
        float wf[8] = {wv[ks][0].x, wv[ks][0].y, wv[ks][0].z, wv[ks][0].w, wv[ks][1].x, wv[ks][1].y, wv[ks][1].z, wv[ks][1].w};
#pragma unroll
        for (int e = 0; e < 8; ++e) wf[e] = (s0 + e <= t) ? wf[e] : 0.f;
        v4u bw; bw.x = pg8::cvt_pk_bf16(wf[0], wf[1]); bw.y = pg8::cvt_pk_bf16(wf[2], wf[3]); bw.z = pg8::cvt_pk_bf16(wf[4], wf[5]); bw.w = pg8::cvt_pk_bf16(wf[6], wf[7]);
        const bf16x8 bfrag = __builtin_bit_cast(bf16x8, bw);
#pragma unroll
        for (int p = 0; p < 4; ++p)
#pragma unroll
            for (int q = 0; q < 2; ++q) {
                const int drow = 32 * p + 8 * (fr >> 2) + 4 * q + (fr & 3);
                const bf16x8 afrag = *(const LAS bf16x8*)(lds + drow * VROW + 64 * ks + 16 * g);
                acc[p][q] = __builtin_amdgcn_mfma_f32_16x16x32_bf16(afrag, bfrag, acc[p][q], 0, 0, 0);
            }
    }
    float v[4][8];
#pragma unroll
    for (int p = 0; p < 4; ++p) {
        float gu[8]; unpack8(guv[p], gu);
#pragma unroll
        for (int q = 0; q < 2; ++q)
#pragma unroll
            for (int e = 0; e < 4; ++e) v[p][4 * q + e] = gu[4 * q + e] * (acc[p][q][e] + bias);
    }
    head_norm_store(v, (size_t)(R0 + t), h * HD, g, A.g_head, heads);
    __syncthreads();
}

__device__ __forceinline__ void conv_unit(const Args& A, int R0, int tpos0, int grp, int tid) {
    const bf16* proj = (const bf16*)(A.ws + WS_PROJ); bf16* heads = (bf16*)(A.ws + WS_HEADS);
    const int lane = tid & 63, w = tid >> 6, fr = lane & 15, g = lane >> 4;
    const int t = 16 * w + fr; const size_t row = (size_t)(R0 + t); const int tpos = tpos0 + t;
    float v[4][8];
#pragma unroll
    for (int p = 0; p < 4; ++p) {
        const int col = grp * HD + 32 * p + 8 * g;
        float y[8];
#pragma unroll
        for (int e = 0; e < 8; ++e) y[e] = 0.f;
#pragma unroll
        for (int k = 0; k < 3; ++k) {
            const int back = 2 - k;
            if (tpos - back >= 0) {
                float c[8], xin[8];
                unpack8(*(const GAS v4u*)(proj + (row - back) * DIN + OFF_C + col), c);
                unpack8(*(const GAS v4u*)(proj + (row - back) * DIN + OFF_X + col), xin);
                const f32x4 k0 = *(const GAS f32x4*)(A.conv_w + k * DCONV + col), k1 = *(const GAS f32x4*)(A.conv_w + k * DCONV + col + 4);
                const float kw[8] = {k0.x, k0.y, k0.z, k0.w, k1.x, k1.y, k1.z, k1.w};
#pragma unroll
                for (int e = 0; e < 8; ++e) y[e] += kw[e] * (c[e] * xin[e]);
            }
        }
        float bg[8]; unpack8(*(const GAS v4u*)(proj + row * DIN + OFF_B + col), bg);
#pragma unroll
        for (int e = 0; e < 8; ++e) v[p][e] = bg[e] * y[e];
    }
    head_norm_store(v, row, DSGU + grp * HD, g, A.g_head, heads);
}

__device__ __forceinline__ void attn_stage(const Args& A, LAS unsigned char* lds, int b, int h, int tid) {
    const bf16* kmat = (const bf16*)(A.ws + WS_KMAT); const bf16* vt = (const bf16*)(A.ws + WS_VT);
#pragma unroll
    for (int it = 0; it < 8; ++it) {
        const int idx = tid + 512 * it;
        { const int key = idx >> 4, ch = idx & 15; const v4u d = *(const GAS v4u*)(kmat + (size_t)(b * NMEM + key) * DMEM + h * HD + 8 * ch); *(LAS v4u*)(lds + key * KROW + 16 * ch) = d; }
        { const int dd = idx >> 5, ch = idx & 31; const v4u d = *(const GAS v4u*)(vt + (size_t)(h * HD + dd) * (NB * NMEM) + b * NMEM + 8 * ch); *(LAS v4u*)(lds + K_BYTES + dd * VTROW + 16 * ch) = d; }
    }
}
__device__ __forceinline__ void attn_chunk(const Args& A, LAS unsigned char* lds, int R0, int h, int tid) {
    const bf16* proj = (const bf16*)(A.ws + WS_PROJ); bf16* heads = (bf16*)(A.ws + WS_HEADS);
    const int lane = tid & 63, w = tid >> 6, fr = lane & 15, g = lane >> 4;
    const size_t row = (size_t)(R0 + 16 * w + fr);
    bf16x8 qf[4];
#pragma unroll
    for (int ks = 0; ks < 4; ++ks) qf[ks] = __builtin_bit_cast(bf16x8, *(const GAS v4u*)(proj + row * DIN + OFF_Q + h * HD + 32 * ks + 8 * g));
    f32x4 sacc[16];
    bf16x8 kf[2][4];
#pragma unroll
    for (int ks = 0; ks < 4; ++ks) kf[0][ks] = *(const LAS bf16x8*)(lds + fr * KROW + 64 * ks + 16 * g);
#pragma unroll
    for (int kt = 0; kt < 16; ++kt) {
        if (kt + 1 < 16) {
#pragma unroll
            for (int ks = 0; ks < 4; ++ks) kf[(kt + 1) & 1][ks] = *(const LAS bf16x8*)(lds + (16 * (kt + 1) + fr) * KROW + 64 * ks + 16 * g);
        }
        sacc[kt] = (f32x4){0.f, 0.f, 0.f, 0.f};
#pragma unroll
        for (int ks = 0; ks < 4; ++ks) sacc[kt] = __builtin_amdgcn_mfma_f32_16x16x32_bf16(kf[kt & 1][ks], qf[ks], sacc[kt], 0, 0, 0);
        asm volatile("" ::: "memory");
    }
    float mx = -3.0e38f;
#pragma unroll
    for (int kt = 0; kt < 16; ++kt) mx = fmaxf(mx, fmaxf(fmaxf(sacc[kt][0], sacc[kt][1]), fmaxf(sacc[kt][2], sacc[kt][3])));
    mx = fmaxf(mx, __shfl_xor(mx, 16)); mx = fmaxf(mx, __shfl_xor(mx, 32));
    float l = 0.f;
#pragma unroll
    for (int kt = 0; kt < 16; ++kt)
#pragma unroll
        for (int e = 0; e < 4; ++e) { const float p = __builtin_amdgcn_exp2f(sacc[kt][e] - mx); sacc[kt][e] = p; l += p; }
    l += __shfl_xor(l, 16); l += __shfl_xor(l, 32);
    f32x4 oacc[4][2];
#pragma unroll
    for (int p = 0; p < 4; ++p)
#pragma unroll
        for (int q = 0; q < 2; ++q) oacc[p][q] = (f32x4){0.f, 0.f, 0.f, 0.f};
    v4u af[2][4][2];
    const LAS unsigned char* vbase = lds + K_BYTES + (8 * (fr >> 2) + (fr & 3)) * VTROW + 8 * g;
#define LOAD_AF(buf, s_) do { _Pragma("unroll") for (int p = 0; p < 4; ++p) _Pragma("unroll") for (int q = 0; q < 2; ++q) { \
        const LAS unsigned char* a0 = vbase + (32 * p + 4 * q) * VTROW + 64 * (s_); const v2u lo_ = *(const LAS v2u*)a0, hi_ = *(const LAS v2u*)(a0 + 32); \
        af[buf][p][q] = (v4u){lo_.x, lo_.y, hi_.x, hi_.y}; } } while (0)
    LOAD_AF(0, 0);
#pragma unroll
    for (int s = 0; s < 8; ++s) {
        if (s + 1 < 8) LOAD_AF((s + 1) & 1, s + 1);
        v4u pw; pw.x = pg8::cvt_pk_bf16(sacc[2 * s][0], sacc[2 * s][1]); pw.y = pg8::cvt_pk_bf16(sacc[2 * s][2], sacc[2 * s][3]); pw.z = pg8::cvt_pk_bf16(sacc[2 * s + 1][0], sacc[2 * s + 1][1]); pw.w = pg8::cvt_pk_bf16(sacc[2 * s + 1][2], sacc[2 * s + 1][3]);
        const bf16x8 pf = __builtin_bit_cast(bf16x8, pw);
#pragma unroll
        for (int p = 0; p < 4; ++p)
#pragma unroll
            for (int q = 0; q < 2; ++q)
                oacc[p][q] = __builtin_amdgcn_mfma_f32_16x16x32_bf16(__builtin_bit_cast(bf16x8, af[s & 1][p][q]), pf, oacc[p][q], 0, 0, 0);
        asm volatile("" ::: "memory");
    }
#undef LOAD_AF
    const float linv = 1.0f / l;
    float v[4][8];
#pragma unroll
    for (int p = 0; p < 4; ++p)
#pragma unroll
        for (int q = 0; q < 2; ++q)
#pragma unroll
            for (int e = 0; e < 4; ++e) v[p][4 * q + e] = oacc[p][q][e] * linv;
    head_norm_store(v, row, DSGU + DCONV + h * HD, g, A.g_head, heads);
}

__global__ void __launch_bounds__(NWAVES * 64, 2) fwd_kernel(Args args) {
    extern __shared__ __attribute__((aligned(16))) unsigned char lds_raw[];
    LAS unsigned char* lds = (LAS unsigned char*)lds_raw;
    volatile LAS unsigned* MISC = (volatile LAS unsigned*)(lds + MISC_OFF);
    const int tid = threadIdx.x, lane = tid & 63, wave = __builtin_amdgcn_readfirstlane(tid >> 6);
    const int G = gridDim.x, bx = blockIdx.x;
    const int vcu = (G % 8 == 0) ? (bx % 8) * (G / 8) + bx / 8 : bx;
    unsigned char* ws = args.ws;
    for (int u = tid; u < (LDS_BYTES - MISC_OFF) / 4; u += NWAVES * 64) ((LAS unsigned*)(lds + MISC_OFF))[u] = 0u;
    __syncthreads();
    XcdBarrier bar; bar.bar = (unsigned*)(ws + WS_CTL) + CW_BAR; bar.x = 0; bar.st = nullptr;
    if (N_LAUNCHES == 1) bar = xcd_barrier_post((unsigned*)(ws + WS_CTL) + CW_BAR, MISC + 8);
    const int lo = args.ph_lo, hi = args.ph_hi;
#define IN(k) (lo <= (k) && (k) < hi)
#define SEAM(k) do { if (IN(k) && IN((k) + 1)) xcd_barrier(bar); } while (0)
    bf16* BIG = (bf16*)(ws + WS_BIG);

    if (IN(0)) {
        LAS unsigned* scr = (LAS unsigned*)(lds + wave * 16384);
        const int gw = vcu * NWAVES + wave, NGW = G * NWAVES;
        constexpr int I_IN = (DM / 64) * (DIN / 64), I_KV = (DM / 64) * (2 * DMEM / 64), I_O = (DM / 64) * (DM / 64), I_1 = (DM / 64) * (DFF / 64), I_2 = (DFF / 64) * (DM / 64);
        constexpr int NITEMS = I_IN + I_KV + I_O + I_1 + I_2;
        for (int it = gw; it < NITEMS; it += NGW) {
            int r = it;
            if (r < I_IN) { p0_transpose_item(args.w_in, DM, DIN, (bf16*)(ws + WS_WIN), nullptr, scr, r, lane); continue; } r -= I_IN;
            if (r < I_KV) { p0_transpose_item(args.w_kv, DM, 2 * DMEM, (bf16*)(ws + WS_WKV), nullptr, scr, r, lane); continue; } r -= I_KV;
            if (r < I_O) { p0_transpose_item(args.w_o, DM, DM, (bf16*)(ws + WS_WO), nullptr, scr, r, lane); continue; } r -= I_O;
            if (r < I_1) { p0_transpose_item(args.w1, DM, DFF, (bf16*)(ws + WS_W1), args.g_ffn, scr, r, lane); continue; } r -= I_1;
            p0_transpose_item(args.w2, DFF, DM, (bf16*)(ws + WS_W2), nullptr, scr, r, lane);
        }
        for (int m = gw; m < M + NB * NMEM; m += NGW) {
            if (m < M) rms_row_to_bf16(args.x + (size_t)m * DM, args.g_mix, (bf16*)(ws + WS_XN) + (size_t)m * DM, lane);
            else rms_row_to_bf16(args.mem + (size_t)(m - M) * DM, args.g_mem, (bf16*)(ws + WS_MEMN) + (size_t)(m - M) * DM, lane);
        }
    }
    SEAM(0);
    if (IN(1)) {
        pg8::Gemm g{BIG, BIG, 0, 0, DM}; pg8::Order1 S; S.init(G, bx, 0, 1024);
        pg8::Epi1 E{(bf16*)(ws + WS_PROJ), (bf16*)(ws + WS_KMAT), (bf16*)(ws + WS_VT), (float*)(ws + WS_VSTATS), QSCALE};
        pg8::gemm_phase<pg8::Epi1, pg8::Order1, true, true>(lds, g, S, E);
    }
    SEAM(1);
    if (IN(2)) {
        {
            pg8::Gemm g{BIG, BIG, 0, 0, DM}; pg8::Order1 S; S.init(G, bx, 1024, 1120);
            pg8::Epi1 E{(bf16*)(ws + WS_PROJ), (bf16*)(ws + WS_KMAT), (bf16*)(ws + WS_VT), (float*)(ws + WS_VSTATS), QSCALE};
            pg8::gemm_phase<pg8::Epi1, pg8::Order1, true, true>(lds, g, S, E);
        }
        unsigned* qhead = (unsigned*)(ws + WS_CTL) + CW_QUEUE;
        __syncthreads();
        if (tid == 0) MISC[16] = atomicAdd(qhead, 1u);
        __syncthreads();
        unsigned u = MISC[16];
        __syncthreads();
        while (u < 1536u) {
            unsigned nt = 0u;
            if (tid == 0) nt = atomicAdd(qhead, 1u);
            if (u < 768u) { const int h = u % 6, bc = u / 6; sgu_unit(args, lds, bc * CHUNK, h, tid); }
            else { const int s2 = u - 768, grp = s2 % 6, bc = s2 / 6; conv_unit(args, bc * CHUNK, (bc & 15) * CHUNK, grp, tid); }
            if (tid == 0) MISC[16] = nt;
            __syncthreads();
            u = MISC[16];
            __syncthreads();
        }
    }
    SEAM(2);
    if (IN(3)) {
        for (int a = vcu; a < 256; a += G) {
            const int bh = a >> 3, cp = a & 7, b = bh >> 2, h = bh & 3;
            attn_stage(args, lds, b, h, tid);
            __syncthreads();
#pragma unroll 1
            for (int r = 0; r < 2; ++r) attn_chunk(args, lds, b * SEQ + (cp + 8 * r) * CHUNK, h, tid);
            __syncthreads();
        }
    }
    SEAM(3);
    if (IN(4)) {
        pg8::Gemm g{(const bf16*)(ws + WS_HEADS), (const bf16*)(ws + WS_WO), M, DM, DM}; pg8::StaticOrder S; S.init(M, DM, G, bx);
        pg8::Epi3 E{args.x, (bf16*)(ws + WS_X1B), (float*)(ws + WS_SSQ1)};
        pg8::gemm_phase<pg8::Epi3, pg8::StaticOrder, true, true>(lds, g, S, E);
    }
    SEAM(4);
    if (IN(5)) {
        pg8::Gemm g{(const bf16*)(ws + WS_X1B), (const bf16*)(ws + WS_W1), M, DFF, DM}; pg8::StaticOrder S; S.init(M, DFF, G, bx);
        pg8::Epi4 E{(bf16*)(ws + WS_HID), (const float*)(ws + WS_SSQ1)};
        pg8::gemm_phase<pg8::Epi4, pg8::StaticOrder, true, true>(lds, g, S, E);
    }
    SEAM(5);
    if (IN(6)) {
        pg8::Gemm g{(const bf16*)(ws + WS_HID), (const bf16*)(ws + WS_W2), M, DM, DFF}; pg8::StaticOrder S; S.init(M, DM, G, bx);
        pg8::Epi5 E{(bf16*)(ws + WS_X1B), (float*)(ws + WS_SSQ2)};
        pg8::gemm_phase<pg8::Epi5, pg8::StaticOrder, true, true>(lds, g, S, E);
    }
    SEAM(6);
    if (IN(7)) {
        const int gw = bx * NWAVES + wave, NGW = G * NWAVES;
        const float* ssq2 = (const float*)(ws + WS_SSQ2);
        for (int m = gw; m < M; m += NGW) {
            const float part = lane < 32 ? ssq2[(size_t)m * 32 + lane] : 0.f;
            const float rinv = 1.0f / sqrtf(wave_sum(part) * (1.f / DM) + EPS);
            const GAS v4u* xr = (const GAS v4u*)((const bf16*)(ws + WS_X1B) + (size_t)m * DM) + lane;
            GAS f32x4* ow = (GAS f32x4*)(args.out + (size_t)m * DM) + 2 * lane; const GAS f32x4* gr = (const GAS f32x4*)args.g_final + 2 * lane;
            v4u v[4];
#pragma unroll
            for (int j = 0; j < 4; ++j) v[j] = xr[64 * j];
#pragma unroll
            for (int j = 0; j < 4; ++j) {
                float f[8]; unpack8(v[j], f); const f32x4 g0 = gr[128 * j], g1 = gr[128 * j + 1];
                ow[128 * j] = (f32x4){f[0] * rinv * g0.x, f[1] * rinv * g0.y, f[2] * rinv * g0.z, f[3] * rinv * g0.w};
                ow[128 * j + 1] = (f32x4){f[4] * rinv * g1.x, f[5] * rinv * g1.y, f[6] * rinv * g1.z, f[7] * rinv * g1.w};
            }
        }
    }
#undef IN
#undef SEAM
}

extern "C" void kernel_launch(void* const* d_in, const int* in_sizes, int n_in, void* d_out, int out_size, void* d_ws, size_t ws_size, hipStream_t stream) {
    static int grid = 0;
    if (grid == 0) {
        if (n_in != 17 || in_sizes[0] != M * DM || out_size != M * DM || ws_size < WS_END) { fprintf(stderr, "kernel_launch: unexpected shapes (n_in %d, in0 %d, out %d, ws %zu); nothing launched\n", n_in, n_in > 0 ? in_sizes[0] : -1, out_size, ws_size); grid = -1; return; }
        int dev = 0, cus = 0, per_cu = 0;
        if (hipGetDevice(&dev) != hipSuccess || hipDeviceGetAttribute(&cus, hipDeviceAttributeMultiprocessorCount, dev) != hipSuccess) { grid = -1; return; }
        if (hipFuncSetAttribute((const void*)fwd_kernel, hipFuncAttributeMaxDynamicSharedMemorySize, LDS_BYTES) != hipSuccess) { fprintf(stderr, "kernel_launch: hipFuncSetAttribute failed\n"); grid = -1; return; }
        if (hipOccupancyMaxActiveBlocksPerMultiprocessor(&per_cu, (const void*)fwd_kernel, NWAVES * 64, LDS_BYTES) != hipSuccess || per_cu < 1) { fprintf(stderr, "kernel_launch: occupancy query says %d blocks per CU\n", per_cu); (void)hipGetLastError(); grid = -1; return; }
        grid = cus;
    }
    if (grid < 0) return;
    (void)hipMemsetAsync((char*)d_ws + WS_CTL, 0, CTL_ZERO_BYTES, stream);
    Args a{};
    const float** p = (const float**)&a;
    for (int i = 0; i < 17; ++i) p[i] = (const float*)d_in[i];
    a.out = (float*)d_out; a.ws = (unsigned char*)d_ws;
    for (int li = 0; li < N_LAUNCHES; ++li) {
        a.ph_lo = (N_LAUNCHES == 1) ? 0 : li; a.ph_hi = (N_LAUNCHES == 1) ? N_PHASES : li + 1;
        hipLaunchKernelGGL(fwd_kernel, dim3(grid), dim3(NWAVES * 64), LDS_BYTES, stream, a);
        const hipError_t le = hipPeekAtLastError();
        if (le != hipSuccess) { fprintf(stderr, "kernel_launch: launch %d failed: %s\n", li, hipGetErrorName(le)); break; }
    }
}
```
